# Optimizing an MI355X kernel written in HIP

```python
import math
import jax, jax.numpy as jnp
from jax import lax
import numpy as np

D_MODEL = 1024
BATCH = 2
SEQ = 8192
DEPTH = 2

N_HEADS_A = 8
D_COMP_A = 32
D_V_A = 2 * D_COMP_A
WIDTH_A = N_HEADS_A * D_V_A
ROPE_DIMS = D_COMP_A // 4
ROPE_THETA = 500000.0
Q_BLOCK = 128
WIDTH_B = 512
CONV_WIDTH = 31
N_GROUPS_C = 4
GROUP_C = 128
WIDTH_C = N_GROUPS_C * GROUP_C
N_BRANCH = 3
IN_WIDTH = 3 * WIDTH_A + 2 * WIDTH_B + WIDTH_C
D_FF = -(-8 * D_MODEL // (3 * 256)) * 256
EPS = 1e-6

kernel_name = 'hybrid_diffattn_conformer_fnet_gated'


def rmsnorm(x, g):
    xf = x.astype(jnp.float32)
    y = xf * lax.rsqrt(jnp.mean(xf * xf, axis=-1, keepdims=True) + EPS)
    return (y * g.astype(jnp.float32)).astype(x.dtype)


def layernorm(x, g, b):
    xf = x.astype(jnp.float32)
    mu = jnp.mean(xf, axis=-1, keepdims=True)
    var = jnp.mean(jnp.square(xf - mu), axis=-1, keepdims=True)
    y = (xf - mu) * lax.rsqrt(var + EPS)
    return (y * g.astype(jnp.float32) + b.astype(jnp.float32)).astype(x.dtype)


def rope_tables(seq):
    pos = jnp.arange(seq, dtype=jnp.float32)
    inv = 1.0 / (ROPE_THETA ** (jnp.arange(0, ROPE_DIMS, 2, dtype=jnp.float32) / ROPE_DIMS))
    ang = pos[:, None] * inv[None, :]
    return jnp.cos(ang), jnp.sin(ang)


def apply_partial_rope(t, cos, sin):
    half = ROPE_DIMS // 2
    c = cos[None, :, None, None, :].astype(t.dtype)
    s = sin[None, :, None, None, :].astype(t.dtype)
    r1 = t[..., :half]
    r2 = t[..., half:ROPE_DIMS]
    rest = t[..., ROPE_DIMS:]
    return jnp.concatenate([r1 * c - r2 * s, r2 * c + r1 * s, rest], axis=-1)


def diff_attention(q, k, v, lam):
    b, s = q.shape[0], q.shape[1]
    nb = s // Q_BLOCK
    qb = q.reshape(b, nb, Q_BLOCK, N_HEADS_A, 2, D_COMP_A).transpose(1, 0, 2, 3, 4, 5)
    vf = v.astype(jnp.float32)
    scale = D_COMP_A ** -0.5

    def block(qi):
        sc = jnp.einsum('bqhcd,bkhcd->bhcqk', qi, k,
                        preferred_element_type=jnp.float32) * scale
        p = jax.nn.softmax(sc, axis=-1)
        w = p[:, :, 0] - lam * p[:, :, 1]
        return jnp.einsum('bhqk,bkhe->bqhe', w, vf)

    out = lax.map(block, qb)
    return out.transpose(1, 0, 2, 3, 4).reshape(b, s, N_HEADS_A, D_V_A).astype(v.dtype)


def setup_inputs(seed: int = 0) -> dict:
    key = jax.random.key(seed)
    ks = jax.random.split(key, 24)
    f32 = jnp.float32
    L, D = DEPTH, D_MODEL

    def nrm(k, shape, scale):
        return jax.random.normal(k, shape, f32) * scale

    return {
        'x': nrm(ks[0], (BATCH, SEQ, D), 1.0),
        'norm1_g': 1.0 + nrm(ks[1], (L, D), 0.02),
        'w_in': nrm(ks[2], (L, D, IN_WIDTH), D ** -0.5),
        'qnorm_g': 1.0 + nrm(ks[3], (L, D_COMP_A), 0.02),
        'knorm_g': 1.0 + nrm(ks[4], (L, D_COMP_A), 0.02),
        'lambda_q1': nrm(ks[5], (L, D_COMP_A), 0.1),
        'lambda_k1': nrm(ks[6], (L, D_COMP_A), 0.1),
        'lambda_q2': nrm(ks[7], (L, D_COMP_A), 0.1),
        'lambda_k2': nrm(ks[8], (L, D_COMP_A), 0.1),
        'subln_g': 1.0 + nrm(ks[9], (L, D_V_A), 0.02),
        'w_proj_a': nrm(ks[10], (L, WIDTH_A, D), WIDTH_A ** -0.5),
        'conv_w': nrm(ks[11], (L, CONV_WIDTH, WIDTH_B), CONV_WIDTH ** -0.5),
        'conv_b': nrm(ks[12], (L, WIDTH_B), 0.02),
        'conv_ln_g': 1.0 + nrm(ks[13], (L, WIDTH_B), 0.02),
        'conv_ln_b': nrm(ks[14], (L, WIDTH_B), 0.02),
        'w_proj_b': nrm(ks[15], (L, WIDTH_B, D), WIDTH_B ** -0.5),
        'w_proj_c': nrm(ks[16], (L, WIDTH_C, D), WIDTH_C ** -0.5),
        'w_gate': nrm(ks[17], (L, D, N_BRANCH * D), D ** -0.5),
        'b_gate': nrm(ks[18], (L, N_BRANCH * D), 0.02),
        'w_out': nrm(ks[19], (L, D, D), D ** -0.5),
        'norm2_g': 1.0 + nrm(ks[20], (L, D), 0.02),
        'w_ffn_in': nrm(ks[21], (L, D, 2 * D_FF), D ** -0.5),
        'w_ffn_out': nrm(ks[22], (L, D_FF, D), D_FF ** -0.5),
    }


def reference(x, norm1_g, w_in, qnorm_g, knorm_g, lambda_q1, lambda_k1, lambda_q2, lambda_k2,
              subln_g, w_proj_a, conv_w, conv_b, conv_ln_g, conv_ln_b, w_proj_b, w_proj_c,
              w_gate, b_gate, w_out, norm2_g, w_ffn_in, w_ffn_out):
    b, s, d = x.shape
    cos, sin = rope_tables(s)
    for l in range(DEPTH):
        h = rmsnorm(x, norm1_g[l])
        u = h @ w_in[l]
        o = 0
        q = u[..., o:o + WIDTH_A].reshape(b, s, N_HEADS_A, 2, D_COMP_A); o += WIDTH_A
        k = u[..., o:o + WIDTH_A].reshape(b, s, N_HEADS_A, 2, D_COMP_A); o += WIDTH_A
        v = u[..., o:o + WIDTH_A].reshape(b, s, N_HEADS_A, D_V_A); o += WIDTH_A
        glu_in = u[..., o:o + 2 * WIDTH_B]; o += 2 * WIDTH_B
        four_in = u[..., o:o + WIDTH_C]

        q = apply_partial_rope(rmsnorm(q, qnorm_g[l]), cos, sin)
        k = apply_partial_rope(rmsnorm(k, knorm_g[l]), cos, sin)
        lam_init = 0.8 - 0.6 * math.exp(-0.3 * l)
        lam = (jnp.exp(jnp.sum(lambda_q1[l].astype(jnp.float32) * lambda_k1[l].astype(jnp.float32)))
               - jnp.exp(jnp.sum(lambda_q2[l].astype(jnp.float32) * lambda_k2[l].astype(jnp.float32)))
               + lam_init)
        att = diff_attention(q, k, v, lam)
        att = rmsnorm(att, subln_g[l]) * (1.0 - lam_init)
        y_a = att.reshape(b, s, WIDTH_A) @ w_proj_a[l]

        ga, gb = jnp.split(glu_in, 2, axis=-1)
        g = ga * jax.nn.sigmoid(gb)
        cv = lax.conv_general_dilated(
            g, conv_w[l].reshape(CONV_WIDTH, 1, WIDTH_B), window_strides=(1,),
            padding=[((CONV_WIDTH - 1) // 2, (CONV_WIDTH - 1) // 2)],
            dimension_numbers=('NWC', 'WIO', 'NWC'), feature_group_count=WIDTH_B)
        cv = layernorm(cv + conv_b[l], conv_ln_g[l], conv_ln_b[l])
        y_b = jax.nn.silu(cv) @ w_proj_b[l]

        fc = four_in.astype(jnp.float32).reshape(b, s, N_GROUPS_C, GROUP_C)
        fr = jnp.fft.fft2(fc, axes=(1, 3), norm='ortho').real.astype(x.dtype)
        y_c = fr.reshape(b, s, WIDTH_C) @ w_proj_c[l]

        gates = jax.nn.sigmoid(h @ w_gate[l] + b_gate[l]).reshape(b, s, N_BRANCH, d)
        merged = gates[:, :, 0] * y_a + gates[:, :, 1] * y_b + gates[:, :, 2] * y_c
        x = x + merged @ w_out[l]

        h2 = rmsnorm(x, norm2_g[l])
        f_gate, f_up = jnp.split(h2 @ w_ffn_in[l], 2, axis=-1)
        x = x + (jax.nn.silu(f_gate) * f_up) @ w_ffn_out[l]
    return x
```

```cpp
#include <hip/hip_runtime.h>
#include <hip/hip_cooperative_groups.h>
#include <cstdio>
#include <cstdint>
namespace cg = cooperative_groups;

#ifndef PHMASK
#define PHMASK 0xFFFF
#endif
#define PHON(b) ((PHMASK >> (b)) & 1)
#ifndef FAST_GEMM
#define FAST_GEMM 1
#endif
#ifndef FAST_ATTN
#define FAST_ATTN 1
#endif
#ifndef MK_ONE_LAUNCH
#define MK_ONE_LAUNCH 1
#endif

#define LAS __attribute__((address_space(3)))
typedef unsigned short bf16_t;
typedef short bf16x8 __attribute__((ext_vector_type(8)));
typedef float f32x4 __attribute__((ext_vector_type(4)));
typedef float f32x2 __attribute__((ext_vector_type(2)));
typedef unsigned u32x4 __attribute__((ext_vector_type(4)));
typedef unsigned u32x2 __attribute__((ext_vector_type(2)));
typedef __bf16 bf16x2_t __attribute__((ext_vector_type(2)));

constexpr int BATCH = 2, SEQ = 8192, DM = 1024, M = BATCH * SEQ, DEPTH = 2;
constexpr int NH = 8, DFF = 2816, CONVW = 31;
constexpr int NIN = 3072, NGATE = 3072, KMRG = 1536, NF1 = 2 * DFF;
constexpr int UP = 2560;
constexpr int AP = 1536;
constexpr float EPS = 1e-6f;
constexpr float QSCALE = 0.17677669529663687f * 1.4426950408889634f;
constexpr int NTHREADS = 512, NWAVES = 8;
constexpr int LDS_BYTES = 147456;
constexpr int NPHASE = 8;

constexpr size_t MiB = 1u << 20;
constexpr size_t WS_ROPE = 0;
constexpr size_t WS_TW = 256 * 1024;
constexpr size_t WS_BAR = 512 * 1024;
constexpr size_t WS_SSQA = 1 * MiB;
constexpr size_t WS_SSQB = 2 * MiB;
constexpr size_t WS_WIN = 4 * MiB;
constexpr size_t WS_WG = 10 * MiB;
constexpr size_t WS_WM = 16 * MiB;
constexpr size_t WS_WO = 19 * MiB;
constexpr size_t WS_WF1 = 21 * MiB;
constexpr size_t WS_WF2 = 32 * MiB;
constexpr size_t WS_WF2B = 248 * MiB;
constexpr size_t WS_XB = 40 * MiB;
constexpr size_t WS_ABUF = 72 * MiB;
constexpr size_t WS_U = 120 * MiB;
constexpr size_t WS_MRG = WS_U;
constexpr size_t WS_GATE = 200 * MiB;
constexpr size_t WS_END = 254 * MiB;

__device__ __forceinline__ unsigned pk2(float lo, float hi) { f32x2 v = {lo, hi}; bf16x2_t b = __builtin_convertvector(v, bf16x2_t); return __builtin_bit_cast(unsigned, b); }
__device__ __forceinline__ float bflo(unsigned u) { return __uint_as_float(u << 16); }
__device__ __forceinline__ float bfhi(unsigned u) { return __uint_as_float(u & 0xffff0000u); }
__device__ __forceinline__ float bf1(bf16_t h) { return __uint_as_float((unsigned)h << 16); }
__device__ __forceinline__ bf16_t f2bf(float f) { return (bf16_t)(pk2(f, 0.f) & 0xffffu); }
__device__ __forceinline__ void store8(bf16_t* p, f32x4 a, f32x4 b) { u32x4 w; w.x = pk2(a[0], a[1]); w.y = pk2(a[2], a[3]); w.z = pk2(b[0], b[1]); w.w = pk2(b[2], b[3]); *(__attribute__((address_space(1))) u32x4*)p = w; }
__device__ __forceinline__ void load8(const bf16_t* p, f32x4& a, f32x4& b) { const u32x4 w = *(const __attribute__((address_space(1))) u32x4*)p; a = (f32x4){bflo(w.x), bfhi(w.x), bflo(w.y), bfhi(w.y)}; b = (f32x4){bflo(w.z), bfhi(w.z), bflo(w.w), bfhi(w.w)}; }
__device__ __forceinline__ float sigmoidf_(float x) { return __builtin_amdgcn_rcpf(1.f + __builtin_amdgcn_exp2f(-1.4426950408889634f * x)); }
__device__ __forceinline__ float row_rstd(const float* ssq, int r) {
    const f32x4* p = (const f32x4*)(ssq + (size_t)r * 16); const f32x4 a = p[0], b = p[1], c = p[2], d = p[3];
    const float s = ((a[0] + a[1]) + (a[2] + a[3])) + ((b[0] + b[1]) + (b[2] + b[3])) + ((c[0] + c[1]) + (c[2] + c[3])) + ((d[0] + d[1]) + (d[2] + d[3]));
    return __builtin_amdgcn_rsqf(s * (1.f / 1024.f) + EPS);
}
__device__ __forceinline__ float wave_sum(float v) {
#pragma unroll
    for (int o = 1; o < 64; o <<= 1) v += __shfl_xor(v, o);
    return v;
}
#define LDS_WAIT() asm volatile("s_waitcnt lgkmcnt(0)" ::: "memory")
__device__ __forceinline__ int my_tid(int w) {
    int l; asm volatile("v_mbcnt_lo_u32_b32 %0, -1, 0\n\tv_mbcnt_hi_u32_b32 %0, -1, %0" : "=v"(l) : "s"(w));
    return w * 64 + l;
}

constexpr int BM = 256, NXCD = 8, WGM = 2;
#define P1_WGM 4
struct Unit { int pm, pn, half; };
struct Gemm { const bf16_t* A; const bf16_t* Bt; int M, N, K; };
__device__ __forceinline__ int perm32(int rho) { const int n = rho >> 4, i = rho & 15; return 8 * (i >> 2) + 4 * n + (i & 3); }
template <int WGM_, int ROT_ = 0> struct StaticOrderT {
    static constexpr bool HALVES = false;
    int nM, nN, nwg, G, c;
    __device__ __forceinline__ void init(int M_, int N_, int G_, int c_) { nM = M_ / BM; nN = N_ / BM; nwg = nM * nN; G = G_; c = c_; }
    __device__ __forceinline__ void map(int wgid, Unit& u) const {
        { const int q = nwg / NXCD, r = nwg % NXCD, xcd = wgid % NXCD, off = wgid / NXCD; wgid = (xcd < r ? xcd * (q + 1) : r * (q + 1) + (xcd - r) * q) + off; }
        const int nig = WGM_ * nN, gid = wgid / nig, fm = gid * WGM_, gsz = (nM - fm) < WGM_ ? (nM - fm) : WGM_;
        u.pm = fm + ((wgid % nig) % gsz); u.pn = (wgid % nig) / gsz; if constexpr (ROT_ != 0) { u.pn += ROT_ * (gid & 1); if (u.pn >= nN) u.pn -= nN; }
    }
    __device__ __forceinline__ bool next(int i, Unit& u) const {
        const long L = (long)i * G + c; if (L >= nwg) return false;
        u.half = 0;
        int wgid = (int)L; { const int q = nwg / NXCD, r = nwg % NXCD, xcd = wgid % NXCD, off = wgid / NXCD; wgid = (xcd < r ? xcd * (q + 1) : r * (q + 1) + (xcd - r) * q) + off; }
        const int nig = WGM_ * nN, gid = wgid / nig, fm = gid * WGM_, gsz = (nM - fm) < WGM_ ? (nM - fm) : WGM_;
        u.pm = fm + ((wgid % nig) % gsz); u.pn = (wgid % nig) / gsz; if constexpr (ROT_ != 0) { u.pn += ROT_ * (gid & 1); if (u.pn >= nN) u.pn -= nN; } return true;
    }
};
using StaticOrder = StaticOrderT<WGM>;

struct TailHalfOrder : StaticOrder {
    static constexpr bool HALVES = true;
    __device__ __forceinline__ bool next(int i, Unit& u) const {
        const int rem = nwg % G, full = nwg / G;
        const bool tail = (2 * rem == G) && (i == full);
        const int L = tail ? full * G + (c % rem) : i * G + c;
        if (L >= nwg) return false;
        int pm_, pn_;
        { int wgid = L; const int q = nwg / NXCD, r = nwg % NXCD, xcd = wgid % NXCD, off = wgid / NXCD; wgid = (xcd < r ? xcd * (q + 1) : r * (q + 1) + (xcd - r) * q) + off;
          const int nig = WGM * nN, gid = wgid / nig, fm = gid * WGM, gsz = (nM - fm) < WGM ? (nM - fm) : WGM; pm_ = fm + ((wgid % nig) % gsz); pn_ = (wgid % nig) / gsz; }
        u.pm = pm_; u.pn = pn_; u.half = tail ? 1 + c / rem : 0; return true;
    }
};

#define FOR_AI_M _Pragma("unroll") for (int ai = 0; ai < 2; ++ai) _Pragma("unroll") for (int m = 0; m < 4; ++m)

template <class Epi>
__device__ __forceinline__ void gemm_phase_simple(LAS unsigned char* lds, const Gemm g, const StaticOrder& S, const Epi& E, int wv) {
    int tid = my_tid(wv);
    const int wid = __builtin_amdgcn_readfirstlane(tid >> 6), lane = tid & 63, wr = wid >> 2, wc = wid & 3, fr = lane & 15, fq = lane >> 4;
    const int K = g.K;
    Unit u;
    for (int i = 0; S.next(i, u); ++i) {
        f32x4 acc[2][2][4][2];
#pragma unroll
        for (int a = 0; a < 2; ++a)
#pragma unroll
            for (int b = 0; b < 2; ++b)
#pragma unroll
                for (int m = 0; m < 4; ++m)
#pragma unroll
                    for (int n = 0; n < 2; ++n) acc[a][b][m][n] = (f32x4){0.f, 0.f, 0.f, 0.f};
        const bf16_t* Ab = g.A + (size_t)(u.pm * BM + wr * 64 + fr) * K + fq * 8;
        const bf16_t* Bb = g.Bt + (size_t)(u.pn * BM + wc * 32) * K + fq * 8;
        const int p0 = perm32(fr), p1 = perm32(16 + fr);
        for (int k0 = 0; k0 < K; k0 += 32) {
            if constexpr (Epi::MID_K > 0) { if (k0 > 0 && (k0 % Epi::MID_K) == 0) E.mid(acc, u, k0 / Epi::MID_K - 1, wr, wc, fr, fq); }
            bf16x8 a[2][4], b[2][2];
#pragma unroll
            for (int ai = 0; ai < 2; ++ai)
#pragma unroll
                for (int m = 0; m < 4; ++m) a[ai][m] = *(const bf16x8*)(Ab + (size_t)(ai * 128 + m * 16) * K + k0);
#pragma unroll
            for (int bj = 0; bj < 2; ++bj) { b[bj][0] = *(const bf16x8*)(Bb + (size_t)(bj * 128 + p0) * K + k0); b[bj][1] = *(const bf16x8*)(Bb + (size_t)(bj * 128 + p1) * K + k0); }
#pragma unroll
            for (int ai = 0; ai < 2; ++ai)
#pragma unroll
                for (int bj = 0; bj < 2; ++bj)
#pragma unroll
                    for (int m = 0; m < 4; ++m)
#pragma unroll
                        for (int n = 0; n < 2; ++n) acc[ai][bj][m][n] = __builtin_amdgcn_mfma_f32_16x16x32_bf16(b[bj][n], a[ai][m], acc[ai][bj][m][n], 0, 0, 0);
        }
        LAS float* rtab = (LAS float*)(lds + 131072);
        if constexpr (Epi::NEED_RSTD) { __syncthreads(); if (tid < 256) rtab[tid] = row_rstd(E.ssq, u.pm * BM + tid); __syncthreads(); }
        E(acc, u, wr, wc, fr, fq, rtab);
    }
}

constexpr int BK = 64, HALF = 128, HTB = HALF * BK * 2, STAGE_BYTES = 8 * HTB;
__host__ __device__ __forceinline__ int lds_byte(int r, int c) { const int st = (r >> 4) * 2 + (c >> 5), rr = r & 15, cc = c & 31, ob = rr * 64 + cc * 2; return st * 1024 + (ob ^ (((ob >> 9) & 1) << 5)); }
__host__ __device__ __forceinline__ void stage_rc(int b, int& R, int& C) { const int st = b / 1024, sb = b % 1024, swz = sb ^ (((sb >> 9) & 1) << 5); R = (st >> 1) * 16 + swz / 64; C = (st & 1) * 32 + (swz % 64) / 2; }
template <class Epi, class Sched, bool ALIGN_EPI = false, bool SP2 = false>
__device__ __forceinline__ void gemm_phase(LAS unsigned char* lds, const Gemm g, const Sched& S, const Epi& E, int wv) {
    int tid = my_tid(wv);
    const int wid = __builtin_amdgcn_readfirstlane(tid >> 6), lane = tid & 63, wr = wid >> 2, wc = wid & 3, fr = lane & 15, fq = lane >> 4;
    const int K = g.K, nt = K / BK;
    unsigned voffA[2], voffB[2];
#pragma unroll
    for (int i = 0; i < 2; ++i) { int R, C; stage_rc(tid * 16 + i * 8192, R, C); const int Rb = (R & ~31) + perm32(R & 31);
        voffA[i] = (unsigned)(R * K + C) * 2u; voffB[i] = (unsigned)(Rb * K + C) * 2u; }
    const size_t kstep = (size_t)(BK * 2);
    const size_t hstep = (size_t)HALF * K * 2;
    const size_t tstep = 2 * hstep;
    const unsigned ldsw = (unsigned)wid * 1024u;
    const int aoff = lds_byte(wr * 64 + fr, fq * 8), boff = lds_byte(wc * 32 + fr, fq * 8);
#define PG8_SA(b, h) (((b) * 2 + (h)) * HTB)
#define PG8_SB(b, h) ((4 + (b) * 2 + (h)) * HTB)
#define PG8_STAGE(bufoff, gbase, voff) do { _Pragma("unroll") for (int _i = 0; _i < 2; ++_i) \
        __builtin_amdgcn_global_load_lds((const unsigned*)((const char*)(gbase) + (voff)[_i]), (LAS unsigned*)(lds + (bufoff) + ldsw + _i * 8192), 16, 0, 0); } while (0)
#define PG8_LDA(dst, b, h) do { _Pragma("unroll") for (int m = 0; m < 4; ++m) _Pragma("unroll") for (int k = 0; k < 2; ++k) dst[m][k] = *(const LAS bf16x8*)(lds + PG8_SA(b, h) + aoff + m * 2048 + k * 1024); } while (0)
#define PG8_LDB(dst, b, h) do { _Pragma("unroll") for (int n = 0; n < 2; ++n) _Pragma("unroll") for (int k = 0; k < 2; ++k) dst[n][k] = *(const LAS bf16x8*)(lds + PG8_SB(b, h) + boff + n * 2048 + k * 1024); } while (0)
#define PG8_MMA(ai, bj, At, Bt) do { __builtin_amdgcn_s_setprio(1); _Pragma("unroll") for (int m = 0; m < 4; ++m) _Pragma("unroll") for (int n = 0; n < 2; ++n) _Pragma("unroll") for (int k = 0; k < 2; ++k) \
        acc[ai][bj][m][n] = __builtin_amdgcn_mfma_f32_16x16x32_bf16(Bt[n][k], At[m][k], acc[ai][bj][m][n], 0, 0, 0); __builtin_amdgcn_s_setprio(0); } while (0)
#define PG8_WAIT_V(n) asm volatile("s_waitcnt vmcnt(" #n ")" ::: "memory")
#define PG8_WAIT_L(n) asm volatile("s_waitcnt lgkmcnt(" #n ")" ::: "memory")
#define PG8_BAR __builtin_amdgcn_s_barrier()
#define PG8_SCHED __builtin_amdgcn_sched_barrier(0)
    Unit cur, nxt; int ui = 0;
    if (!S.next(0, cur)) return;
    f32x4 acc[2][2][4][2];
#pragma unroll
    for (int a = 0; a < 2; ++a)
#pragma unroll
        for (int b = 0; b < 2; ++b)
#pragma unroll
            for (int m = 0; m < 4; ++m)
#pragma unroll
                for (int n = 0; n < 2; ++n) acc[a][b][m][n] = (f32x4){0.f, 0.f, 0.f, 0.f};
    bf16x8 At[4][2], B0[2][2], B1[2][2];
    const char* cA = (const char*)g.A + (size_t)cur.pm * tstep; const char* cB = (const char*)g.Bt + (size_t)cur.pn * tstep;
    if constexpr (SP2) {
        PG8_STAGE(PG8_SB(0, 0), cB, voffB); PG8_STAGE(PG8_SB(0, 1), cB + hstep, voffB); PG8_STAGE(PG8_SA(0, 0), cA, voffA); PG8_STAGE(PG8_SA(0, 1), cA + hstep, voffA);
        if (wr == 1) PG8_BAR;
        PG8_WAIT_V(2); PG8_BAR;
        PG8_STAGE(PG8_SB(1, 0), cB + kstep, voffB); PG8_STAGE(PG8_SA(1, 0), cA + kstep, voffA); PG8_STAGE(PG8_SB(1, 1), cB + hstep + kstep, voffB);
        PG8_WAIT_V(6); PG8_BAR;
    } else {
        PG8_STAGE(PG8_SB(0, 0), cB, voffB); PG8_STAGE(PG8_SA(0, 0), cA, voffA); PG8_STAGE(PG8_SB(0, 1), cB + hstep, voffB); PG8_STAGE(PG8_SA(0, 1), cA + hstep, voffA);
        if (wr == 1) PG8_BAR;
        PG8_WAIT_V(4); PG8_BAR;
        PG8_STAGE(PG8_SB(1, 0), cB + kstep, voffB); PG8_STAGE(PG8_SA(1, 0), cA + kstep, voffA); PG8_STAGE(PG8_SB(1, 1), cB + hstep + kstep, voffB);
        PG8_WAIT_V(6); PG8_BAR;
    }
    for (;;) {
        const bool has_next = S.next(ui + 1, nxt);
        const char* nA = has_next ? (const char*)g.A + (size_t)nxt.pm * tstep : cA; const char* nB = has_next ? (const char*)g.Bt + (size_t)nxt.pn * tstep : cB;
        for (int t = 0; t < nt; t += 2) {
            const bool last = (t == nt - 2);
            const char* a1 = cA + (size_t)(t + 1) * kstep;
            const char* a2 = last ? nA : cA + (size_t)(t + 2) * kstep; const char* b2 = last ? nB : cB + (size_t)(t + 2) * kstep;
            const char* a3 = a2 + kstep; const char* b3 = b2 + kstep;
            if constexpr (Epi::MID_K > 0) { if (t > 0 && (t * BK) % Epi::MID_K == 0) E.mid(acc, cur, (t * BK) / Epi::MID_K - 1, wr, wc, fr, fq); }
            if constexpr (SP2) {
            PG8_LDB(B0, 0, 0); PG8_LDB(B1, 0, 1); PG8_SCHED; PG8_LDA(At, 0, 0); PG8_STAGE(PG8_SA(1, 1), a1 + hstep, voffA);
            PG8_WAIT_V(8); PG8_WAIT_L(0); PG8_BAR; if (!Sched::HALVES || cur.half != 2) { PG8_MMA(0, 0, At, B0); PG8_MMA(0, 1, At, B1); } PG8_BAR; PG8_SCHED;
            PG8_LDA(At, 0, 1); PG8_STAGE(PG8_SB(0, 0), b2, voffB); PG8_STAGE(PG8_SB(0, 1), b2 + hstep, voffB); PG8_STAGE(PG8_SA(0, 0), a2, voffA);
            PG8_WAIT_V(8); PG8_WAIT_L(0); PG8_BAR; if (!Sched::HALVES || cur.half != 1) { PG8_MMA(1, 0, At, B0); PG8_MMA(1, 1, At, B1); } PG8_BAR; PG8_SCHED;
            PG8_LDB(B0, 1, 0); PG8_LDB(B1, 1, 1); PG8_SCHED; PG8_LDA(At, 1, 0); PG8_STAGE(PG8_SA(0, 1), a2 + hstep, voffA);
            PG8_WAIT_V(8); PG8_WAIT_L(0); PG8_BAR; if (!Sched::HALVES || cur.half != 2) { PG8_MMA(0, 0, At, B0); PG8_MMA(0, 1, At, B1); } PG8_BAR; PG8_SCHED;
            PG8_LDA(At, 1, 1); PG8_STAGE(PG8_SB(1, 0), b3, voffB); PG8_STAGE(PG8_SB(1, 1), b3 + hstep, voffB); PG8_STAGE(PG8_SA(1, 0), a3, voffA);
            PG8_WAIT_V(8); PG8_WAIT_L(0); PG8_BAR; if (!Sched::HALVES || cur.half != 1) { PG8_MMA(1, 0, At, B0); PG8_MMA(1, 1, At, B1); } PG8_BAR; PG8_SCHED;
            } else {
            PG8_LDB(B0, 0, 0); PG8_SCHED; PG8_LDA(At, 0, 0); PG8_STAGE(PG8_SA(1, 1), a1 + hstep, voffA);
            PG8_WAIT_L(8); PG8_BAR; PG8_WAIT_L(0); PG8_MMA(0, 0, At, B0); PG8_BAR; PG8_SCHED;
            PG8_LDB(B1, 0, 1); PG8_STAGE(PG8_SB(0, 0), b2, voffB);
            PG8_BAR; PG8_WAIT_L(0); PG8_MMA(0, 1, At, B1); PG8_BAR;
            PG8_LDA(At, 0, 1); PG8_STAGE(PG8_SA(0, 0), a2, voffA);
            PG8_BAR; PG8_WAIT_L(0); PG8_MMA(1, 0, At, B0); PG8_BAR; PG8_SCHED;
            PG8_STAGE(PG8_SB(0, 1), b2 + hstep, voffB);
            PG8_WAIT_V(6); PG8_BAR; PG8_MMA(1, 1, At, B1); PG8_BAR;
            PG8_LDB(B0, 1, 0); PG8_SCHED; PG8_LDA(At, 1, 0); PG8_STAGE(PG8_SA(0, 1), a2 + hstep, voffA);
            PG8_WAIT_L(8); PG8_BAR; PG8_WAIT_L(0); PG8_MMA(0, 0, At, B0); PG8_BAR; PG8_SCHED;
            PG8_LDB(B1, 1, 1); PG8_STAGE(PG8_SB(1, 0), b3, voffB);
            PG8_BAR; PG8_WAIT_L(0); PG8_MMA(0, 1, At, B1); PG8_BAR;
            PG8_LDA(At, 1, 1); PG8_STAGE(PG8_SA(1, 0), a3, voffA);
            PG8_BAR; PG8_WAIT_L(0); PG8_MMA(1, 0, At, B0); PG8_BAR; PG8_SCHED;
            PG8_STAGE(PG8_SB(1, 1), b3 + hstep, voffB);
            PG8_WAIT_V(6); PG8_BAR; PG8_MMA(1, 1, At, B1); PG8_BAR;
            }
        }
        if constexpr (ALIGN_EPI) { if (wr == 0) PG8_BAR; }
        LAS float* rtab = (LAS float*)(lds + STAGE_BYTES);
        if constexpr (Epi::NEED_RSTD) { if (tid < 256) rtab[tid] = row_rstd(E.ssq, cur.pm * BM + tid); asm volatile("s_waitcnt lgkmcnt(0)" ::: "memory"); PG8_BAR; asm volatile("" ::: "memory"); }
        E(acc, cur, wr, wc, fr, fq, rtab);
        if (!has_next) break;
#pragma unroll
        for (int a = 0; a < 2; ++a)
#pragma unroll
            for (int b = 0; b < 2; ++b)
#pragma unroll
                for (int m = 0; m < 4; ++m)
#pragma unroll
                    for (int n = 0; n < 2; ++n) acc[a][b][m][n] = (f32x4){0.f, 0.f, 0.f, 0.f};
        cur = nxt; cA = nA; cB = nB; ++ui;
        if constexpr (ALIGN_EPI) { if (wr == 1) PG8_BAR; }
    }
    PG8_WAIT_V(0);
    if constexpr (!ALIGN_EPI) { if (wr == 0) PG8_BAR; }
    PG8_BAR;
#undef PG8_SA
#undef PG8_SB
#undef PG8_STAGE
#undef PG8_LDA
#undef PG8_LDB
#undef PG8_MMA
#undef PG8_WAIT_V
#undef PG8_WAIT_L
#undef PG8_BAR
#undef PG8_SCHED
}

struct EpiIn {
    static constexpr int MID_K = 0; static constexpr bool NEED_RSTD = true;
    bf16_t* U; const float* ssq; const float* gq; const float* gk; const f32x2* rope;
    __device__ __forceinline__ void operator()(f32x4 (&acc)[2][2][4][2], const Unit& u, int wr, int wc, int fr, int fq, LAS const float* rtab) const {
        const int pn = u.pn;
        if (pn < 4) {
            typedef __attribute__((address_space(1))) f32x4 gf32x4;
            const float* gg = pn < 2 ? gq : gk; const float qs = pn < 2 ? QSCALE : 1.f;
            const f32x4 g0 = *(const gf32x4*)(gg + 8 * fq) * qs, g1 = *(const gf32x4*)(gg + 8 * fq + 4) * qs;
#pragma unroll
            for (int ai = 0; ai < 2; ++ai) {
                f32x4 cs[4][2];
#pragma unroll
                for (int m = 0; m < 4; ++m) { const int pos = (u.pm * BM + ai * 128 + wr * 64 + m * 16 + fr) & (SEQ - 1);
                    cs[m][0] = *(const gf32x4*)(rope + pos * 4); cs[m][1] = *(const gf32x4*)(rope + pos * 4 + 2); }
#pragma unroll
                for (int m = 0; m < 4; ++m) {
                    const int r = u.pm * BM + ai * 128 + wr * 64 + m * 16 + fr;
                    const float rs = rtab[ai * 128 + wr * 64 + m * 16 + fr];
                    bf16_t* urow = U + (size_t)r * UP;
#pragma unroll
                    for (int bj = 0; bj < 2; ++bj) {
                        f32x4 v0 = acc[ai][bj][m][0] * rs, v1 = acc[ai][bj][m][1] * rs;
                        float ss = (v0[0] * v0[0] + v0[1] * v0[1]) + (v0[2] * v0[2] + v0[3] * v0[3]) + (v1[0] * v1[0] + v1[1] * v1[1]) + (v1[2] * v1[2] + v1[3] * v1[3]);
                        ss += __shfl_xor(ss, 16); ss += __shfl_xor(ss, 32);
                        const float inv = __builtin_amdgcn_rsqf(ss * (1.f / 32.f) + EPS);
                        v0 = v0 * inv * g0; v1 = v1 * inv * g1;
                        if (fq == 0) {
#pragma unroll
                            for (int i = 0; i < 4; ++i) { const float c_ = cs[m][i >> 1][(i & 1) * 2], s_ = cs[m][i >> 1][(i & 1) * 2 + 1]; const float a = v0[i], b = v1[i]; v0[i] = a * c_ - b * s_; v1[i] = b * c_ + a * s_; }
                        }
                        store8(urow + pn * 256 + bj * 128 + wc * 32 + 8 * fq, v0, v1);
                    }
                }
            }
            return;
        }
        FOR_AI_M {
            const int r = u.pm * BM + ai * 128 + wr * 64 + m * 16 + fr;
            const float rs = rtab[ai * 128 + wr * 64 + m * 16 + fr];
            bf16_t* urow = U + (size_t)r * UP;
            if (pn < 6) {
#pragma unroll
                for (int bj = 0; bj < 2; ++bj) store8(urow + pn * 256 + bj * 128 + wc * 32 + 8 * fq, acc[ai][bj][m][0] * rs, acc[ai][bj][m][1] * rs);
            } else if (pn < 10) {
                f32x4 o[2];
                const float irs = __builtin_amdgcn_rcpf(rs);
#pragma unroll
                for (int n = 0; n < 2; ++n) { const f32x4 gb = acc[ai][1][m][n] * (rs * -1.4426950408889634f);
#pragma unroll
                    for (int j = 0; j < 4; ++j) o[n][j] = acc[ai][0][m][n][j] * __builtin_amdgcn_rcpf(__builtin_fmaf(__builtin_amdgcn_exp2f(gb[j]), irs, irs)); }
                store8(urow + 1536 + (pn - 6) * 128 + wc * 32 + 8 * fq, o[0], o[1]);
            } else {
#pragma unroll
                for (int bj = 0; bj < 2; ++bj) store8(urow + 2048 + (pn - 10) * 256 + bj * 128 + wc * 32 + 8 * fq, acc[ai][bj][m][0] * rs, acc[ai][bj][m][1] * rs);
            }
        }
    }
};
__device__ __forceinline__ size_t gates_off(int pm, int pn12, int wr, int wc, int e, int fr, int fq) { return ((((size_t)(pm * 12 + pn12) * 8 + (wr * 4 + wc)) * 16 + e) * 64 + (fq * 16 + fr)) * 8; }
typedef unsigned u32x2_t __attribute__((ext_vector_type(2)));
struct EpiGate {
    static constexpr int MID_K = 0; static constexpr bool NEED_RSTD = true;
    unsigned char* Gt; const float* ssq; const float* bias;
    __device__ __forceinline__ void operator()(f32x4 (&acc)[2][2][4][2], const Unit& u, int wr, int wc, int fr, int fq, LAS const float* rtab) const {
        const int c0 = u.pn * BM + wc * 32 + 8 * fq;
        typedef __attribute__((address_space(1))) f32x4 gf32x4;
        f32x4 bvn[2][2];
#pragma unroll
        for (int bj = 0; bj < 2; ++bj)
#pragma unroll
            for (int n = 0; n < 2; ++n) bvn[bj][n] = *(const gf32x4*)(bias + c0 + bj * 128 + 4 * n) * -1.4426950408889634f;
        FOR_AI_M {
            const int r = u.pm * BM + ai * 128 + wr * 64 + m * 16 + fr;
            const float rsn = rtab[ai * 128 + wr * 64 + m * 16 + fr] * -1.4426950408889634f;
#pragma unroll
            for (int bj = 0; bj < 2; ++bj) { u32x2_t w = {0u, 0u};
#pragma unroll
                for (int n = 0; n < 2; ++n) { const f32x4 bv = bvn[bj][n];
#pragma unroll
                    for (int j = 0; j < 4; ++j) {
                        const float e = __builtin_amdgcn_exp2f(acc[ai][bj][m][n][j] * rsn + bv[j]);
                        const float q = fmaxf(__builtin_amdgcn_rcpf(e * (1.f / 255.f) + (1.f / 255.f)), 1.f);
                        w[n] = __builtin_amdgcn_cvt_pk_u8_f32(q, j, w[n]); } }
                *(__attribute__((address_space(1))) u32x2_t*)(Gt + gates_off(u.pm, u.pn, wr, wc, ai * 8 + m * 2 + bj, fr, fq)) = w; }
        }
    }
};
struct EpiInGate {
    static constexpr int MID_K = 0; static constexpr bool NEED_RSTD = true;
    EpiIn a; EpiGate g; const float* ssq;
    __device__ __forceinline__ void operator()(f32x4 (&acc)[2][2][4][2], const Unit& u, int wr, int wc, int fr, int fq, LAS const float* rtab) const {
        if (u.pn < 12) a(acc, u, wr, wc, fr, fq, rtab);
        else { Unit v = u; v.pn = u.pn - 12; g(acc, v, wr, wc, fr, fq, rtab); }
    }
};
__device__ __forceinline__ void loadq8(const unsigned char* p, f32x4& a, f32x4& b) { const u32x2_t w = *(const u32x2_t*)p;
    a = (f32x4){(float)(w.x & 0xffu), (float)((w.x >> 8) & 0xffu), (float)((w.x >> 16) & 0xffu), (float)(w.x >> 24)};
    b = (f32x4){(float)(w.y & 0xffu), (float)((w.y >> 8) & 0xffu), (float)((w.y >> 16) & 0xffu), (float)(w.y >> 24)}; }
struct EpiMerge {
    static constexpr int MID_K = 512; static constexpr bool NEED_RSTD = false; const float* ssq;
    const unsigned char* Gt; bf16_t* Mg;
    __device__ __forceinline__ void mid(f32x4 (&acc)[2][2][4][2], const Unit& u, int seg, int wr, int wc, int fr, int fq) const {
        typedef __attribute__((address_space(1))) u32x2_t gu32x2;
#pragma unroll
        for (int ai = 0; ai < 2; ++ai) {
            u32x2_t qa[4][2], qb[4][2];
#pragma unroll
            for (int m = 0; m < 4; ++m)
#pragma unroll
                for (int bj = 0; bj < 2; ++bj) { const int e = ai * 8 + m * 2 + bj;
                    qa[m][bj] = *(const gu32x2*)(Gt + gates_off(u.pm, seg * 4 + u.pn, wr, wc, e, fr, fq)); qb[m][bj] = *(const gu32x2*)(Gt + gates_off(u.pm, (seg + 1) * 4 + u.pn, wr, wc, e, fr, fq)); }
#pragma unroll
            for (int m = 0; m < 4; ++m)
#pragma unroll
                for (int bj = 0; bj < 2; ++bj) { const u32x2_t wa = qa[m][bj], wb = qb[m][bj];
                    const f32x4 a0 = (f32x4){(float)(wa.x & 0xffu), (float)((wa.x >> 8) & 0xffu), (float)((wa.x >> 16) & 0xffu), (float)(wa.x >> 24)}, a1 = (f32x4){(float)(wa.y & 0xffu), (float)((wa.y >> 8) & 0xffu), (float)((wa.y >> 16) & 0xffu), (float)(wa.y >> 24)};
                    const f32x4 b0 = (f32x4){(float)(wb.x & 0xffu), (float)((wb.x >> 8) & 0xffu), (float)((wb.x >> 16) & 0xffu), (float)(wb.x >> 24)}, b1 = (f32x4){(float)(wb.y & 0xffu), (float)((wb.y >> 8) & 0xffu), (float)((wb.y >> 16) & 0xffu), (float)(wb.y >> 24)};
#pragma unroll
                    for (int j = 0; j < 4; ++j) { acc[ai][bj][m][0][j] *= a0[j] * __builtin_amdgcn_rcpf(b0[j]); acc[ai][bj][m][1][j] *= a1[j] * __builtin_amdgcn_rcpf(b1[j]); } }
        }
    }
    __device__ __forceinline__ void operator()(f32x4 (&acc)[2][2][4][2], const Unit& u, int wr, int wc, int fr, int fq, LAS const float* rtab) const {
        const int c0 = u.pn * BM + wc * 32 + 8 * fq;
        typedef __attribute__((address_space(1))) u32x2_t gu32x2;
#pragma unroll
        for (int ai = 0; ai < 2; ++ai) {
            u32x2_t gq[4][2];
#pragma unroll
            for (int m = 0; m < 4; ++m)
#pragma unroll
                for (int bj = 0; bj < 2; ++bj) gq[m][bj] = *(const gu32x2*)(Gt + gates_off(u.pm, 8 + u.pn, wr, wc, ai * 8 + m * 2 + bj, fr, fq));
#pragma unroll
            for (int m = 0; m < 4; ++m) {
                const int r = u.pm * BM + ai * 128 + wr * 64 + m * 16 + fr;
#pragma unroll
                for (int bj = 0; bj < 2; ++bj) { const u32x2_t w = gq[m][bj];
                    const f32x4 a0 = (f32x4){(float)(w.x & 0xffu), (float)((w.x >> 8) & 0xffu), (float)((w.x >> 16) & 0xffu), (float)(w.x >> 24)};
                    const f32x4 a1 = (f32x4){(float)(w.y & 0xffu), (float)((w.y >> 8) & 0xffu), (float)((w.y >> 16) & 0xffu), (float)(w.y >> 24)};
                    store8(Mg + (size_t)r * DM + c0 + bj * 128, acc[ai][bj][m][0] * (a0 * (1.f / 255.f)), acc[ai][bj][m][1] * (a1 * (1.f / 255.f))); }
            }
        }
    }
};
template <bool FINAL>
struct EpiRes {
    static constexpr int MID_K = 0; static constexpr bool NEED_RSTD = false;
    float* out; bf16_t* xb; float* ssq;
    __device__ __forceinline__ void operator()(f32x4 (&acc)[2][2][4][2], const Unit& u, int wr, int wc, int fr, int fq, LAS const float* rtab) const {
        typedef __attribute__((address_space(1))) u32x4 gu32x4;
        const int c0 = u.pn * BM + wc * 32 + 8 * fq;
#pragma unroll
        for (int ai = 0; ai < 2; ++ai) {
            u32x4 xr[4][2];
#pragma unroll
            for (int m = 0; m < 4; ++m)
#pragma unroll
                for (int bj = 0; bj < 2; ++bj) xr[m][bj] = *(const gu32x4*)(xb + (size_t)(u.pm * BM + ai * 128 + wr * 64 + m * 16 + fr) * DM + c0 + bj * 128);
#pragma unroll
            for (int m = 0; m < 4; ++m) {
                const int r = u.pm * BM + ai * 128 + wr * 64 + m * 16 + fr;
                float ss = 0.f;
#pragma unroll
                for (int bj = 0; bj < 2; ++bj) {
                    const size_t off = (size_t)r * DM + c0 + bj * 128;
                    const u32x4 w = xr[m][bj];
                    const f32x4 b0 = (f32x4){bflo(w.x), bfhi(w.x), bflo(w.y), bfhi(w.y)}, b1 = (f32x4){bflo(w.z), bfhi(w.z), bflo(w.w), bfhi(w.w)};
                    const f32x4 x0 = b0 + acc[ai][bj][m][0], x1 = b1 + acc[ai][bj][m][1];
                    if constexpr (FINAL) { *(f32x4*)(out + off) = x0; *(f32x4*)(out + off + 4) = x1; }
                    else store8(xb + off, x0, x1);
                    ss += (x0[0] * x0[0] + x0[1] * x0[1]) + (x0[2] * x0[2] + x0[3] * x0[3]) + (x1[0] * x1[0] + x1[1] * x1[1]) + (x1[2] * x1[2] + x1[3] * x1[3]);
                }
                ss += __shfl_xor(ss, 16); ss += __shfl_xor(ss, 32);
                if (!FINAL && fq == 0) ssq[(size_t)r * 16 + u.pn * 4 + wc] = ss;
            }
        }
    }
};
struct EpiFfnIn {
    static constexpr int MID_K = 0; static constexpr bool NEED_RSTD = true;
    bf16_t* HF; const float* ssq;
    __device__ __forceinline__ void operator()(f32x4 (&acc)[2][2][4][2], const Unit& u, int wr, int wc, int fr, int fq, LAS const float* rtab) const {
        FOR_AI_M {
            if (u.half && ai != u.half - 1) continue;
            const int r = u.pm * BM + ai * 128 + wr * 64 + m * 16 + fr;
            const float rs = rtab[ai * 128 + wr * 64 + m * 16 + fr];
            f32x4 o[2];
            const float irs2 = __builtin_amdgcn_rcpf(rs * rs);
#pragma unroll
            for (int n = 0; n < 2; ++n) { const f32x4 gt = acc[ai][0][m][n] * (rs * -1.4426950408889634f), gu = acc[ai][0][m][n] * acc[ai][1][m][n];
#pragma unroll
                for (int j = 0; j < 4; ++j) o[n][j] = gu[j] * __builtin_amdgcn_rcpf(__builtin_fmaf(__builtin_amdgcn_exp2f(gt[j]), irs2, irs2)); }
            store8(HF + (size_t)r * DFF + u.pn * 128 + wc * 32 + 8 * fq, o[0], o[1]);
        }
    }
};

struct Args { const float* in[23]; float* out; unsigned char* ws; int ph_lo, ph_hi; };
#define INP(A, k) ({ int i_ = (k); asm volatile("" : "+s"(i_)); (A).in[i_]; })
enum { I_X = 0, I_N1G, I_WIN, I_QNG, I_KNG, I_LQ1, I_LK1, I_LQ2, I_LK2, I_SUBG, I_WPA, I_CW, I_CB, I_CLG, I_CLB, I_WPB, I_WPC, I_WGATE, I_BGATE, I_WOUT, I_N2G, I_WF1, I_WF2 };

__device__ __forceinline__ int fperm(int kx) {
    const int g = kx >> 7, kp = (kx & 127) >> 2, i = kx & 3;
    const int col = kp == 0 ? (i == 0 ? 0 : (i == 1 ? 1 : (i == 2 ? 127 : 64))) : (i == 0 ? 2 * kp : (i == 1 ? 2 * kp + 1 : (i == 2 ? 127 - 2 * kp : 128 - 2 * kp)));
    return g * 128 + col;
}
__device__ __forceinline__ void tr_item(const float* W, int ldw, int srccol, const float* rowscale, bf16_t* WT, int ldk, int koff, int k0, int n0, LAS float* scr, int lane, bool rowperm = false) {
    float tv[32];
#pragma unroll
    for (int i = 0; i < 32; ++i) { const int kk = 2 * i + (lane >> 5); const int kx = rowperm ? fperm(k0 + kk) : k0 + kk; tv[i] = __builtin_nontemporal_load(W + (size_t)kx * ldw + srccol + (lane & 31)); }
#pragma unroll
    for (int i = 0; i < 32; ++i) { const int kk = 2 * i + (lane >> 5); float v = tv[i]; if (rowscale) v *= rowscale[k0 + kk]; scr[kk * 33 + (lane & 31)] = v; }
    LDS_WAIT();
    const int c = lane & 7;
#pragma unroll
    for (int j = 0; j < 4; ++j) { const int n = (lane >> 3) + 8 * j; const LAS float* s = scr + (8 * c) * 33 + n;
        u32x4 o; o.x = pk2(s[0 * 33], s[1 * 33]); o.y = pk2(s[2 * 33], s[3 * 33]); o.z = pk2(s[4 * 33], s[5 * 33]); o.w = pk2(s[6 * 33], s[7 * 33]);
        *(u32x4*)(WT + (size_t)(n0 + n) * ldk + koff + k0 + 8 * c) = o; }
    LDS_WAIT();
}

__device__ __forceinline__ void p0_prep(const Args& A, int layer, LAS unsigned char* lds, int G, int wv) {
    int tid = my_tid(wv);
    const int lane = tid & 63, wave = __builtin_amdgcn_readfirstlane(tid >> 6);
    unsigned char* ws = A.ws;
    LAS float* scr = (LAS float*)(lds + wave * 16384);
    LAS f32x2* cs128 = (LAS f32x2*)(lds + 8 * 16384);
    if (tid < 128) { float s, c; sincospif((float)tid * (1.f / 64.f), &s, &c); cs128[tid] = (f32x2){c, s}; }
    __syncthreads();
    const int gw = blockIdx.x * NWAVES + wave, NGW = G * NWAVES;
    const float* w_in = INP(A, I_WIN) + (size_t)layer * DM * NIN; const float* n1g = INP(A, I_N1G) + layer * DM; const float* n2g = INP(A, I_N2G) + layer * DM;
    const float* w_gate = INP(A, I_WGATE) + (size_t)layer * DM * NGATE;
    const float* wpa = INP(A, I_WPA) + (size_t)layer * 512 * DM; const float* wpb = INP(A, I_WPB) + (size_t)layer * 512 * DM; const float* wpc = INP(A, I_WPC) + (size_t)layer * 512 * DM;
    const float* w_out = INP(A, I_WOUT) + (size_t)layer * DM * DM;
    const float* wf1 = INP(A, I_WF1) + (size_t)layer * DM * NF1; const float* wf2 = INP(A, I_WF2) + (size_t)layer * DFF * DM;
    bf16_t* Win_t = (bf16_t*)(ws + WS_WIN); bf16_t* Wg_t = (bf16_t*)(ws + WS_WG); bf16_t* Wm_t = (bf16_t*)(ws + WS_WM); bf16_t* Wo_t = (bf16_t*)(ws + WS_WO);
    bf16_t* Wf1_t = (bf16_t*)(ws + WS_WF1); bf16_t* Wf2_t = (bf16_t*)(ws + ((layer & 1) ? WS_WF2B : WS_WF2));
    constexpr int I_A = 16 * 80, I_B = 16 * 96, I_C = 3 * 8 * 32, I_D = 16 * 32, I_E = 16 * 176, I_F = 44 * 32, NITEMS = I_A + I_B + I_C + I_D + I_E + I_F;
    for (int it = gw; it < NITEMS; it += NGW) {
        int r = it;
        if (r < I_A) { const int kb = r / 80, nb = r % 80, n0 = nb * 32; int src = n0;
            if (n0 >= 1536) { const int t = (n0 - 1536) >> 8, w = (n0 - 1536) & 255; src = 1536 + (w >> 7) * 512 + t * 128 + (w & 127); }
            tr_item(w_in, NIN, src, n1g, Win_t, DM, 0, kb * 64, n0, scr, lane); continue; } r -= I_A;
        if (r < I_B) { const int kb = r / 96, nb = r % 96; tr_item(w_gate, NGATE, nb * 32, n1g, Wg_t, DM, 0, kb * 64, nb * 32, scr, lane); continue; } r -= I_B;
        if (r < I_C) { const int br = r / 256, q = r % 256, kb = q / 32, nb = q % 32; const float* W = br == 0 ? wpa : (br == 1 ? wpb : wpc);
            tr_item(W, DM, nb * 32, nullptr, Wm_t, KMRG, br * 512, kb * 64, nb * 32, scr, lane, br == 2); continue; } r -= I_C;
        if (r < I_D) { const int kb = r / 32, nb = r % 32; tr_item(w_out, DM, nb * 32, nullptr, Wo_t, DM, 0, kb * 64, nb * 32, scr, lane); continue; } r -= I_D;
        if (r < I_E) { const int kb = r / 176, nb = r % 176, n0 = nb * 32; const int t = n0 >> 8, w = n0 & 255; const int src = (w >> 7) * DFF + t * 128 + (w & 127);
            tr_item(wf1, NF1, src, n2g, Wf1_t, DM, 0, kb * 64, n0, scr, lane); continue; } r -= I_E;
        { const int kb = r / 32, nb = r % 32; tr_item(wf2, DM, nb * 32, nullptr, Wf2_t, DFF, 0, kb * 64, nb * 32, scr, lane); }
    }
    for (int it = gw; it < DM * 4; it += NGW) {
        const int k = __builtin_amdgcn_readfirstlane(it >> 2), g = __builtin_amdgcn_readfirstlane(it & 3);
        const float* wr_ = w_in + (size_t)k * NIN + 2560 + g * 128;
        const int j0 = lane, j1 = lane + 64, q0 = j0 >> 1, q1 = j1 >> 1; float s0 = 0.f, s1 = 0.f;
#pragma unroll 16
        for (int c = 0; c < 128; ++c) { const float wv_ = wr_[c];
            const f32x2 e0 = cs128[(q0 * c) & 127], e1 = cs128[(q1 * c) & 127];
            float t0 = (j0 & 1) ? -e0.y : e0.x; if (j0 < 2) t0 = (j0 == 0 || !(c & 1)) ? 1.f : -1.f;
            const float t1 = (j1 & 1) ? -e1.y : e1.x;
            s0 += wv_ * t0; s1 += wv_ * t1; }
        const float sc = n1g[k] * (1.f / 1024.f);
        Win_t[(size_t)(2560 + g * 128 + j0) * DM + k] = f2bf(s0 * sc); Win_t[(size_t)(2560 + g * 128 + j1) * DM + k] = f2bf(s1 * sc);
    }
    if (layer == 0) {
        const float* x = INP(A, I_X); bf16_t* XB = (bf16_t*)(ws + WS_XB); float* ssq = (float*)(ws + WS_SSQA);
        for (int m0 = gw * 2; m0 < M; m0 += NGW * 2) {
            f32x4 v[2][4];
#pragma unroll
            for (int rr = 0; rr < 2; ++rr) { const f32x4* xr = (const f32x4*)(x + (size_t)(m0 + rr) * DM) + lane;
#pragma unroll
                for (int j = 0; j < 4; ++j) v[rr][j] = xr[64 * j]; }
#pragma unroll
            for (int rr = 0; rr < 2; ++rr) { u32x2* o8 = (u32x2*)(XB + (size_t)(m0 + rr) * DM) + lane; float s = 0.f;
#pragma unroll
                for (int j = 0; j < 4; ++j) { const f32x4 w = v[rr][j]; s += (w[0] * w[0] + w[1] * w[1]) + (w[2] * w[2] + w[3] * w[3]); o8[64 * j] = (u32x2){pk2(w[0], w[1]), pk2(w[2], w[3])}; }
                s = wave_sum(s);
                if (lane < 16) ssq[(size_t)(m0 + rr) * 16 + lane] = lane == 0 ? s : 0.f; }
        }
        f32x2* rope = (f32x2*)(ws + WS_ROPE); f32x2* tw = (f32x2*)(ws + WS_TW);
        for (int o = blockIdx.x * NTHREADS + tid; o < SEQ * 4; o += G * NTHREADS) {
            const int pos = o >> 2, i = o & 3; const float inv = i == 0 ? 1.0f : (i == 1 ? 0.037606031f : (i == 2 ? 0.0014142136f : 5.3183104e-05f));
            const float ang = (float)pos * inv; double t = (double)ang * 0.15915494309189535; t -= __builtin_rint(t); float s, c; sincospif((float)(2.0 * t), &s, &c); rope[o] = (f32x2){c, s};
        }
        for (int o = blockIdx.x * NTHREADS + tid; o < SEQ; o += G * NTHREADS) { float s, c; sincospif((float)o * (1.f / 4096.f), &s, &c); tw[o] = (f32x2){c, -s}; }
    }
}

__device__ __forceinline__ void attn_unit_ref(const Args& A, int layer, int unit, LAS unsigned char* lds, int wv) {
    int tid = my_tid(wv); unsigned char* ws = A.ws;
    const bf16_t* U = (const bf16_t*)(ws + WS_U); bf16_t* AB = (bf16_t*)(ws + WS_ABUF);
    const int b = unit >> 9, h = (unit >> 6) & 7, qb = unit & 63;
    const int qrow = tid & 127, comp = (tid >> 7) & 1, dh = tid >> 8;
    const float* gq = INP(A, I_QNG) + layer * 32; const float* gk = INP(A, I_KNG) + layer * 32;
    float gqm = 0.f, gkm = 0.f;
    for (int i = 0; i < 32; ++i) { gqm = fmaxf(gqm, fabsf(gq[i])); gkm = fmaxf(gkm, fabsf(gk[i])); }
    const float bound = QSCALE * 32.f * gqm * gkm;
    float d1 = 0.f, d2 = 0.f;
    for (int i = 0; i < 32; ++i) { d1 += INP(A, I_LQ1)[layer * 32 + i] * INP(A, I_LK1)[layer * 32 + i]; d2 += INP(A, I_LQ2)[layer * 32 + i] * INP(A, I_LK2)[layer * 32 + i]; }
    const float lam_init = 0.8f - 0.6f * expf(-0.3f * (float)layer);
    const float lam = expf(d1) - expf(d2) + lam_init;
    LAS float* Kt = (LAS float*)lds;
    LAS float* Vt = Kt + 64 * 64;
    const size_t tok0 = (size_t)b * SEQ;
    float q[32];
    { const bf16_t* qp = U + (tok0 + qb * 128 + qrow) * UP + h * 64 + comp * 32;
#pragma unroll
      for (int i = 0; i < 4; ++i) { f32x4 a0, a1; load8(qp + 8 * i, a0, a1);
#pragma unroll
          for (int j = 0; j < 4; ++j) { q[8 * i + j] = a0[j]; q[8 * i + 4 + j] = a1[j]; } } }
    float o[32]; float l = 0.f;
#pragma unroll
    for (int i = 0; i < 32; ++i) o[i] = 0.f;
    for (int kt = 0; kt < SEQ / 64; ++kt) {
        __syncthreads();
        { const int row = tid >> 3, ch = tid & 7; const bf16_t* kp = U + (tok0 + kt * 64 + row) * UP + 512 + h * 64 + ch * 8; const bf16_t* vp = U + (tok0 + kt * 64 + row) * UP + 1024 + h * 64 + ch * 8;
          f32x4 a0, a1; load8(kp, a0, a1); *(LAS f32x4*)(Kt + row * 64 + ch * 8) = a0; *(LAS f32x4*)(Kt + row * 64 + ch * 8 + 4) = a1;
          load8(vp, a0, a1); *(LAS f32x4*)(Vt + row * 64 + ch * 8) = a0; *(LAS f32x4*)(Vt + row * 64 + ch * 8 + 4) = a1; }
        __syncthreads();
#pragma unroll 1
        for (int kk = 0; kk < 64; ++kk) {
            const LAS float* kr = Kt + kk * 64 + comp * 32; float s = 0.f;
#pragma unroll
            for (int d = 0; d < 32; d += 4) { const f32x4 kv = *(const LAS f32x4*)(kr + d); s += q[d] * kv[0] + q[d + 1] * kv[1] + q[d + 2] * kv[2] + q[d + 3] * kv[3]; }
            const float e = exp2f(s - bound); l += e;
            const LAS float* vr = Vt + kk * 64 + dh * 32;
#pragma unroll
            for (int d = 0; d < 32; d += 4) { const f32x4 vv = *(const LAS f32x4*)(vr + d); o[d] += e * vv[0]; o[d + 1] += e * vv[1]; o[d + 2] += e * vv[2]; o[d + 3] += e * vv[3]; }
        }
    }
    __syncthreads();
    LAS float* X = (LAS float*)lds;
    const float il = 1.f / l;
    if (comp == 0) {
#pragma unroll
        for (int d = 0; d < 32; ++d) X[qrow * 65 + dh * 32 + d] = o[d] * il;
    }
    __syncthreads();
    if (comp == 1) {
#pragma unroll
        for (int d = 0; d < 32; ++d) X[qrow * 65 + dh * 32 + d] -= lam * o[d] * il;
    }
    __syncthreads();
    if (tid < 128) {
        const float* sg = INP(A, I_SUBG) + layer * 64; float ss = 0.f;
#pragma unroll 8
        for (int d = 0; d < 64; ++d) { const float v = X[tid * 65 + d]; ss += v * v; }
        const float inv = (1.f - lam_init) / sqrtf(ss * (1.f / 64.f) + EPS);
        bf16_t* op = AB + (tok0 + qb * 128 + tid) * AP + h * 64;
#pragma unroll 2
        for (int i = 0; i < 8; ++i) { f32x4 a0, a1;
#pragma unroll
            for (int j = 0; j < 4; ++j) { a0[j] = X[tid * 65 + 8 * i + j] * inv * sg[8 * i + j]; a1[j] = X[tid * 65 + 8 * i + 4 + j] * inv * sg[8 * i + 4 + j]; }
            store8(op + 8 * i, a0, a1); }
    }
    __syncthreads();
}

typedef float f32x16 __attribute__((ext_vector_type(16)));
typedef short s16x4 __attribute__((ext_vector_type(4)));
typedef short v4i16_t __attribute__((ext_vector_type(4)));
constexpr int AK_ROWB = 144, AK_BYTES = 64 * AK_ROWB, AV_BYTES = 8192;
constexpr int ARING = 5;
constexpr int ALDS_K = 0, ALDS_V = ARING * AK_BYTES, ALDS_WS = ALDS_V + ARING * AV_BYTES, ALDS_STG = 0, ASTG_ROW = 68, ASTG_BYTES = 32 * ASTG_ROW * 4, ALDS_END = ALDS_WS + NWAVES * 256;
static_assert(NWAVES * ASTG_BYTES <= ALDS_WS, "attention output stage overlays the K/V rings only");
static_assert(ALDS_END <= LDS_BYTES, "attention LDS map");
__device__ __forceinline__ int crow(int r, int hi) { return (r & 3) + 8 * (r >> 2) + 4 * hi; }
__device__ __forceinline__ s16x4 vtr(LAS const unsigned char* p) { return __builtin_bit_cast(s16x4, __builtin_amdgcn_ds_read_tr16_b64_v4i16((LAS v4i16_t*)p)); }

#define SBAR() __builtin_amdgcn_sched_barrier(0)
__device__ __forceinline__ bf16x8 kfrag(LAS const unsigned char* kb, int Gq) {
    return *(LAS const bf16x8*)(kb + (Gq < 4 ? 1 : 0) * 32 * AK_ROWB + (4 * (Gq & 1) + 2 * ((Gq >> 1) & 1)) * 16); }
template <int G>
__device__ __forceinline__ void attn_hgroup(f32x16 (&o)[2][2], f32x16 (&S)[2][2], u32x4 (&PW)[2][4], s16x4 (&vl)[4], s16x4 (&vh)[4], bf16x8 (&kf)[4], const bf16x8 (&qr)[2][2],
                                            LAS const unsigned char* vb, LAS const unsigned char* vbn, LAS const unsigned char* kbA, LAS const unsigned char* kbB,
                                            f32x4& la, f32x4& lb, const bf16x8& sel, const f32x16& zero16) {
    constexpr int c = G & 1, ks = G >> 1, hf = ks >> 1, s_ = ks & 1, PB = G < 4 ? 2 : 0;
    if constexpr (c == 0) { constexpr int kn = (ks + 1) & 3; LAS const unsigned char* vp = ks == 3 ? vbn : vb;
#pragma unroll
        for (int d0 = 0; d0 < 2; ++d0) { vl[(kn & 1) * 2 + d0] = vtr(vp + d0 * 4096 + kn * 1024); vh[(kn & 1) * 2 + d0] = vtr(vp + d0 * 4096 + kn * 1024 + 512); } }
    kf[(G + 2) & 3] = kfrag(G < 2 ? kbA : kbB, (G + 2) & 7);
    const bf16x8 pa = __builtin_bit_cast(bf16x8, PW[c][ks]);
    const s16x4 v0l = vl[(ks & 1) * 2], v0h = vh[(ks & 1) * 2], v1l = vl[(ks & 1) * 2 + 1], v1h = vh[(ks & 1) * 2 + 1];
    const bf16x8 vf0 = (bf16x8){v0l[0], v0l[1], v0l[2], v0l[3], v0h[0], v0h[1], v0h[2], v0h[3]}, vf1 = (bf16x8){v1l[0], v1l[1], v1l[2], v1l[3], v1h[0], v1h[1], v1h[2], v1h[3]};
    float e[8];
    __builtin_amdgcn_s_setprio(PB + 1); SBAR(); o[c][0] = __builtin_amdgcn_mfma_f32_32x32x16_bf16(pa, vf0, o[c][0], 0, 0, 0);
#pragma unroll
    for (int j = 0; j < 3; ++j) e[j] = __builtin_amdgcn_exp2f(S[c][hf][8 * s_ + j]);
    asm volatile("" : "+v"(e[0]), "+v"(e[1]), "+v"(e[2]));
    SBAR();
    o[c][1] = __builtin_amdgcn_mfma_f32_32x32x16_bf16(pa, vf1, o[c][1], 0, 0, 0);
#pragma unroll
    for (int j = 3; j < 6; ++j) e[j] = __builtin_amdgcn_exp2f(S[c][hf][8 * s_ + j]);
    asm volatile("" : "+v"(e[3]), "+v"(e[4]), "+v"(e[5]));
    SBAR();
    if constexpr (c == 0) { la = __builtin_amdgcn_mfma_f32_16x16x32_bf16(pa, sel, la, 0, 0, 0); asm volatile("" : "+v"(la)); }
    else { lb = __builtin_amdgcn_mfma_f32_16x16x32_bf16(pa, sel, lb, 0, 0, 0); asm volatile("" : "+v"(lb)); }
    e[6] = __builtin_amdgcn_exp2f(S[c][hf][8 * s_ + 6]);
    asm volatile("" : "+v"(e[6]));
    SBAR();
    { constexpr int qc = G & 1, qk = (G >> 1) & 1, qh = G < 4 ? 1 : 0;
      if constexpr (qk == 0) S[qc][qh] = __builtin_amdgcn_mfma_f32_32x32x16_bf16(kf[G & 3], qr[qc][0], zero16, 0, 0, 0);
      else S[qc][qh] = __builtin_amdgcn_mfma_f32_32x32x16_bf16(kf[G & 3], qr[qc][1], S[qc][qh], 0, 0, 0);
      __builtin_amdgcn_s_setprio(PB); }
    e[7] = __builtin_amdgcn_exp2f(S[c][hf][8 * s_ + 7]);
    PW[c][ks] = (u32x4){pk2(e[0], e[1]), pk2(e[2], e[3]), pk2(e[4], e[5]), pk2(e[6], e[7])};
    asm volatile("" : "+v"(PW[c][ks]));
    SBAR();
}

__device__ __forceinline__ void attn_unit_fast(const Args& A, int layer, int unit, LAS unsigned char* lds, float bound, float lam, float lam_init, int wv) {
    int tid = my_tid(wv); unsigned char* ws = A.ws;
    const int lane = tid & 63, r32 = lane & 31, hi = lane >> 5, wid = __builtin_amdgcn_readfirstlane(tid >> 6);
    const bf16_t* U = (const bf16_t*)(ws + WS_U); bf16_t* AB = (bf16_t*)(ws + WS_ABUF);
    const int b = unit >> 8, h = (unit >> 5) & 7, qb = unit & 31;
    const size_t tok0 = (size_t)b * SEQ; const int q0 = qb * 256 + wid * 32;
    const int srow = tid >> 3, sch = tid & 7;
    const bf16_t* kg = U + (tok0 + srow) * UP + 512 + h * 64 + sch * 8;
    const bf16_t* vg = U + (tok0 + srow) * UP + 1024 + h * 64 + sch * 8;
        const unsigned char* kgb = (const unsigned char*)(U + tok0 * UP + 512 + h * 64);
    const unsigned gvo = (unsigned)(srow * UP + sch * 8) * 2u;
    const __amdgpu_buffer_rsrc_t kvrs = __builtin_amdgcn_make_buffer_rsrc((void*)kgb, 0, 0x7fffffff, 0x00020000);
#define KTILE(j) __builtin_amdgcn_raw_buffer_load_b128(kvrs, (int)gvo, (int)((j) * (64 * UP * 2)), 0)
#define VTILE(j) __builtin_amdgcn_raw_buffer_load_b128(kvrs, (int)gvo + 1024, (int)((j) * (64 * UP * 2)), 0)
    const int kwo = srow * AK_ROWB + sch * 16, vwo = (sch >> 2) * 4096 + (srow >> 4) * 1024 + (srow & 15) * 64 + (sch & 3) * 16;
    const int kro = r32 * AK_ROWB + hi * 16;
    const int vro = ((lane >> 4) & 1) * 32 + (lane & 3) * 8 + (4 * hi + ((lane & 15) >> 2)) * 64;
    bf16x8 qr[2][2];
    { const bf16_t* qp = U + (tok0 + q0 + r32) * UP + h * 64 + hi * 8;
#pragma unroll
      for (int c = 0; c < 2; ++c)
#pragma unroll
          for (int ks = 0; ks < 2; ++ks) qr[c][ks] = *(const bf16x8*)(qp + c * 32 + ks * 16); }
    const f32x16 zero16 = {0.f, 0.f, 0.f, 0.f, 0.f, 0.f, 0.f, 0.f, 0.f, 0.f, 0.f, 0.f, 0.f, 0.f, 0.f, 0.f};
    f32x16 o[2][2];
#pragma unroll
    for (int c = 0; c < 2; ++c)
#pragma unroll
        for (int d0 = 0; d0 < 2; ++d0) o[c][d0] = zero16;
    const short selv = (((lane >> 4) ^ lane) & 1) ? (short)0 : (short)0x3F80;
    const bf16x8 sel = (bf16x8){selv, selv, selv, selv, selv, selv, selv, selv};
    f32x4 l0 = {0.f, 0.f, 0.f, 0.f}, l1 = {0.f, 0.f, 0.f, 0.f};
    constexpr int NT = SEQ / 64;
    f32x16 S[2][2]; u32x4 PW[2][4]; bf16x8 kf[4]; s16x4 vl[4], vh[4];
    __syncthreads();
    typedef __attribute__((address_space(1))) u32x4 gu32x4_;
    u32x4 kst, vst;
    const u32x4 k0_ = *(const gu32x4_*)kg, k1_ = *(const gu32x4_*)(kg + (size_t)1 * 64 * UP), v0_ = *(const gu32x4_*)vg;
    const u32x4 k2_ = *(const gu32x4_*)(kg + (size_t)2 * 64 * UP), k3_ = *(const gu32x4_*)(kg + (size_t)3 * 64 * UP), v1_ = *(const gu32x4_*)(vg + (size_t)1 * 64 * UP), v2_ = *(const gu32x4_*)(vg + (size_t)2 * 64 * UP);
    kst = *(const gu32x4_*)(kg + (size_t)4 * 64 * UP); vst = *(const gu32x4_*)(vg + (size_t)3 * 64 * UP);
    *(LAS u32x4*)(lds + ALDS_K + kwo) = k0_; *(LAS u32x4*)(lds + ALDS_K + AK_BYTES + kwo) = k1_; *(LAS u32x4*)(lds + ALDS_V + vwo) = v0_;
    __syncthreads();
    { LAS const unsigned char* kb_ = lds + ALDS_K + kro;
      bf16x8 k8[8];
#pragma unroll
      for (int i_ = 0; i_ < 8; ++i_) k8[i_] = *(LAS const bf16x8*)(kb_ + ((i_ >> 1) & 1) * 32 * AK_ROWB + (4 * (i_ >> 2) + 2 * (i_ & 1)) * 16);
#pragma unroll
      for (int c = 0; c < 2; ++c)
#pragma unroll
          for (int hf = 0; hf < 2; ++hf) { S[c][hf] = __builtin_amdgcn_mfma_f32_32x32x16_bf16(k8[c * 4 + hf * 2], qr[c][0], zero16, 0, 0, 0);
              S[c][hf] = __builtin_amdgcn_mfma_f32_32x32x16_bf16(k8[c * 4 + hf * 2 + 1], qr[c][1], S[c][hf], 0, 0, 0); }
#pragma unroll
      for (int c = 0; c < 2; ++c)
#pragma unroll
          for (int hf = 0; hf < 2; ++hf) {
#pragma unroll
              for (int r = 0; r < 16; ++r) S[c][hf][r] = __builtin_amdgcn_exp2f(S[c][hf][r]);
#pragma unroll
              for (int s_ = 0; s_ < 2; ++s_) PW[c][hf * 2 + s_] = (u32x4){pk2(S[c][hf][8 * s_], S[c][hf][8 * s_ + 1]), pk2(S[c][hf][8 * s_ + 2], S[c][hf][8 * s_ + 3]), pk2(S[c][hf][8 * s_ + 4], S[c][hf][8 * s_ + 5]), pk2(S[c][hf][8 * s_ + 6], S[c][hf][8 * s_ + 7])};
          }
      LAS const unsigned char* kb1_ = lds + ALDS_K + AK_BYTES + kro;
#pragma unroll
      for (int c = 0; c < 2; ++c) { S[c][0] = __builtin_amdgcn_mfma_f32_32x32x16_bf16(kfrag(kb1_, 4 + c), qr[c][0], zero16, 0, 0, 0);
          S[c][0] = __builtin_amdgcn_mfma_f32_32x32x16_bf16(kfrag(kb1_, 6 + c), qr[c][1], S[c][0], 0, 0, 0); }
      kf[0] = kfrag(kb1_, 0); kf[1] = kfrag(kb1_, 1);
      LAS const unsigned char* vb0_ = lds + ALDS_V + vro;
#pragma unroll
      for (int d0 = 0; d0 < 2; ++d0) { vl[d0] = vtr(vb0_ + d0 * 4096); vh[d0] = vtr(vb0_ + d0 * 4096 + 512); }
    }
    *(LAS u32x4*)(lds + ALDS_K + 2 * AK_BYTES + kwo) = k2_; *(LAS u32x4*)(lds + ALDS_K + 3 * AK_BYTES + kwo) = k3_;
    *(LAS u32x4*)(lds + ALDS_V + AV_BYTES + vwo) = v1_; *(LAS u32x4*)(lds + ALDS_V + 2 * AV_BYTES + vwo) = v2_;
    asm volatile("s_waitcnt lgkmcnt(0)" ::: "memory"); __syncthreads();
#define A_W5(x) ((x) >= ARING ? (x) - ARING : (x))
#define A_STEP(t, BAR) do { \
        const int s1_ = A_W5(sv + 1), s2_ = A_W5(sv + 2), s3_ = A_W5(sv + 3), s4_ = A_W5(sv + 4); \
        LAS const unsigned char* vb = vbP; LAS const unsigned char* vbn = lds + ALDS_V + s1_ * AV_BYTES + vro; \
        LAS const unsigned char* kbA = kbP; LAS const unsigned char* kbB = lds + ALDS_K + s2_ * AK_BYTES + kro; \
        attn_hgroup<0>(o, S, PW, vl, vh, kf, qr, vb, vbn, kbA, kbB, l0, l1, sel, zero16); attn_hgroup<1>(o, S, PW, vl, vh, kf, qr, vb, vbn, kbA, kbB, l0, l1, sel, zero16); \
        attn_hgroup<2>(o, S, PW, vl, vh, kf, qr, vb, vbn, kbA, kbB, l0, l1, sel, zero16); attn_hgroup<3>(o, S, PW, vl, vh, kf, qr, vb, vbn, kbA, kbB, l0, l1, sel, zero16); \
        { *(LAS u32x4*)(lds + ALDS_K + s4_ * AK_BYTES + kwo) = kst; *(LAS u32x4*)(lds + ALDS_V + s3_ * AV_BYTES + vwo) = vst; \
          const int kj_ = (t) + 4 < NT ? (t) + 4 : NT - 1, vj_ = (t) + 3 < NT ? (t) + 3 : NT - 1; \
          kst = KTILE(kj_); vst = VTILE(vj_); SBAR(); } \
        attn_hgroup<4>(o, S, PW, vl, vh, kf, qr, vb, vbn, kbA, kbB, l0, l1, sel, zero16); attn_hgroup<5>(o, S, PW, vl, vh, kf, qr, vb, vbn, kbA, kbB, l0, l1, sel, zero16); \
        attn_hgroup<6>(o, S, PW, vl, vh, kf, qr, vb, vbn, kbA, kbB, l0, l1, sel, zero16); attn_hgroup<7>(o, S, PW, vl, vh, kf, qr, vb, vbn, kbA, kbB, l0, l1, sel, zero16); \
        if (BAR) { asm volatile("s_waitcnt lgkmcnt(0)" ::: "memory"); __builtin_amdgcn_s_barrier(); asm volatile("" ::: "memory"); } \
        sv = s1_; vbP = vbn; kbP = kbB; } while (0)
    int sv = 0;
    LAS const unsigned char* vbP = lds + ALDS_V + vro; LAS const unsigned char* kbP = lds + ALDS_K + AK_BYTES + kro;
#pragma unroll 1
    for (int t = 1; t < NT - 1; t += 2) { A_STEP(t, false); A_STEP(t + 1, true); }
    A_STEP(NT - 1, false);
#undef A_STEP
#undef A_W5
#undef KTILE
#undef VTILE
    typedef __attribute__((address_space(1))) f32x4 gf32x4_;
    const float* sg = INP(A, I_SUBG) + layer * 64;
    const f32x4 g0 = *(const gf32x4_*)(sg + (lane & 7) * 8), g1 = *(const gf32x4_*)(sg + (lane & 7) * 8 + 4);
    {
        LAS const unsigned char* vb_ = lds + ALDS_V + ((NT - 1) % ARING) * AV_BYTES + vro;
        s16x4 tl_[4][2], th_[4][2];
#pragma unroll
        for (int ks = 0; ks < 4; ++ks)
#pragma unroll
            for (int d0 = 0; d0 < 2; ++d0) { tl_[ks][d0] = vtr(vb_ + d0 * 4096 + ks * 1024); th_[ks][d0] = vtr(vb_ + d0 * 4096 + ks * 1024 + 512); }
#pragma unroll
        for (int ks = 0; ks < 4; ++ks)
#pragma unroll
            for (int d0 = 0; d0 < 2; ++d0) {
                const s16x4 lo_ = tl_[ks][d0], hi_ = th_[ks][d0];
                const bf16x8 vf_ = (bf16x8){lo_[0], lo_[1], lo_[2], lo_[3], hi_[0], hi_[1], hi_[2], hi_[3]};
                o[0][d0] = __builtin_amdgcn_mfma_f32_32x32x16_bf16(__builtin_bit_cast(bf16x8, PW[0][ks]), vf_, o[0][d0], 0, 0, 0);
                o[1][d0] = __builtin_amdgcn_mfma_f32_32x32x16_bf16(__builtin_bit_cast(bf16x8, PW[1][ks]), vf_, o[1][d0], 0, 0, 0); }
#pragma unroll
        for (int ks = 0; ks < 4; ++ks) {
            l0 = __builtin_amdgcn_mfma_f32_16x16x32_bf16(__builtin_bit_cast(bf16x8, PW[0][ks]), sel, l0, 0, 0, 0);
            l1 = __builtin_amdgcn_mfma_f32_16x16x32_bf16(__builtin_bit_cast(bf16x8, PW[1][ks]), sel, l1, 0, 0, 0); }
    }
    asm volatile("s_waitcnt lgkmcnt(0)" ::: "memory"); __syncthreads();
    LAS float* wsf = (LAS float*)(lds + ALDS_WS) + wid * 64;
    if ((lane & 15) < 2) {
#pragma unroll
        for (int r = 0; r < 4; ++r) { const int qr_ = 4 * (lane >> 4) + r + 16 * (lane & 15); wsf[qr_] = __builtin_amdgcn_rcpf(l0[r]); wsf[32 + qr_] = lam * __builtin_amdgcn_rcpf(l1[r]); } }
    LDS_WAIT();
    LAS float* stg = (LAS float*)(lds + ALDS_STG + wid * ASTG_BYTES);
#pragma unroll
    for (int r = 0; r < 16; ++r) { const int row = crow(r, hi); const float i0 = wsf[row], i1 = wsf[32 + row];
#pragma unroll
        for (int d0 = 0; d0 < 2; ++d0) stg[row * ASTG_ROW + d0 * 32 + r32] = o[0][d0][r] * i0 - o[1][d0][r] * i1; }
    LDS_WAIT();
    const int ch = lane & 7;
#pragma unroll
    for (int i = 0; i < 4; ++i) { const int row = i * 8 + (lane >> 3);
        const f32x4 v0 = *(LAS const f32x4*)(stg + row * ASTG_ROW + ch * 8), v1 = *(LAS const f32x4*)(stg + row * ASTG_ROW + ch * 8 + 4);
        float ss = (v0[0] * v0[0] + v0[1] * v0[1]) + (v0[2] * v0[2] + v0[3] * v0[3]) + (v1[0] * v1[0] + v1[1] * v1[1]) + (v1[2] * v1[2] + v1[3] * v1[3]);
        ss += __shfl_xor(ss, 1); ss += __shfl_xor(ss, 2); ss += __shfl_xor(ss, 4);
        const float inv = (1.f - lam_init) * __builtin_amdgcn_rsqf(ss * (1.f / 64.f) + EPS);
        store8(AB + (tok0 + q0 + row) * AP + h * 64 + ch * 8, v0 * inv * g0, v1 * inv * g1); }
    __syncthreads();
}


__device__ __forceinline__ void conv_item(const Args& A, int layer, int item, LAS unsigned char* lds, int wv) {
    int tid = my_tid(wv); const int lane = tid & 63, wave = tid >> 6; unsigned char* ws = A.ws;
    const bf16_t* U = (const bf16_t*)(ws + WS_U); bf16_t* AB = (bf16_t*)(ws + WS_ABUF);
    const int b = item >> 7, t0 = (item & 127) * 64, c = tid;
    const float* cw = INP(A, I_CW) + (size_t)layer * CONVW * 512;
    float w[CONVW], prev[CONVW], cur[CONVW], nxt[CONVW];
#pragma unroll
    for (int j = 0; j < CONVW; ++j) { w[j] = cw[j * 512 + c]; prev[j] = 0.f; }
    const float bias = INP(A, I_CB)[layer * 512 + c];
    LAS float* T = (LAS float*)lds;
    LAS f32x2* st = (LAS f32x2*)(lds + 64 * 513 * 4);
    const bf16_t* gin = U + ((size_t)b * SEQ) * UP + 1536 + c;
    __syncthreads();
#define CV_LOAD(dst, base) do { unsigned short raw_[CONVW]; \
        _Pragma("unroll") for (int p = 0; p < CONVW; ++p) { const int r = (base) + p, ti = t0 + r - 15; const int tc = ti < 0 ? 0 : (ti > SEQ - 1 ? SEQ - 1 : ti); raw_[p] = gin[(size_t)tc * UP]; } \
        _Pragma("unroll") for (int p = 0; p < CONVW; ++p) { const int r = (base) + p, ti = t0 + r - 15; dst[p] = (r < 94 && ti >= 0 && ti < SEQ) ? bf1(raw_[p]) : 0.f; } } while (0)
    CV_LOAD(prev, 0); CV_LOAD(cur, CONVW);
    { float s = bias;
#pragma unroll
      for (int j = 0; j < CONVW; ++j) s += prev[j] * w[j];
      T[0 * 513 + c] = s; }
#pragma unroll 1
    for (int base = CONVW; base < 3 * CONVW; base += CONVW) {
        CV_LOAD(nxt, base + CONVW);
#pragma unroll
        for (int p = 0; p < CONVW; ++p) {
            float s = bias;
#pragma unroll
            for (int j = 0; j < CONVW; ++j) { const int q = p - 30 + j; s += (q < 0 ? prev[q + CONVW] : cur[q]) * w[j]; }
            T[(base + p - 30) * 513 + c] = s;
        }
#pragma unroll
        for (int p = 0; p < CONVW; ++p) { prev[p] = cur[p]; cur[p] = nxt[p]; }
    }
    { float s = bias;
#pragma unroll
      for (int j = 0; j < CONVW; ++j) s += (j < 30 ? prev[j + 1] : cur[0]) * w[j];
      T[63 * 513 + c] = s; }
#undef CV_LOAD
    __syncthreads();
#pragma unroll
    for (int i = 0; i < 8; ++i) { const int t = wave * 8 + i; float s = 0.f, s2 = 0.f;
#pragma unroll
        for (int k = 0; k < 8; ++k) { const float v = T[t * 513 + lane + 64 * k]; s += v; }
        s = wave_sum(s); const float mean = s * (1.f / 512.f);
#pragma unroll
        for (int k = 0; k < 8; ++k) { const float v = T[t * 513 + lane + 64 * k] - mean; s2 += v * v; }
        s2 = wave_sum(s2);
        if (lane == 0) st[t] = (f32x2){mean, 1.0f / sqrtf(s2 * (1.f / 512.f) + EPS)}; }
    __syncthreads();
    const float lg = INP(A, I_CLG)[layer * 512 + c], lb = INP(A, I_CLB)[layer * 512 + c];
    bf16_t* op = AB + ((size_t)b * SEQ + t0) * AP + 512 + c;
#pragma unroll 8
    for (int t = 0; t < 64; ++t) { const f32x2 s = st[t]; const float y = (T[t * 513 + c] - s.x) * s.y * lg + lb; op[(size_t)t * AP] = f2bf(y * sigmoidf_(y)); }
    __syncthreads();
}

constexpr float C32[16] = {1.0f, 0.98078528040323043f, 0.92387953251128674f, 0.83146961230254524f, 0.70710678118654757f, 0.55557023301960229f, 0.38268343236508984f, 0.19509032201612833f,
                           0.0f, -0.19509032201612819f, -0.38268343236508973f, -0.55557023301960196f, -0.70710678118654746f, -0.83146961230254535f, -0.92387953251128674f, -0.98078528040323043f};
constexpr float S32[16] = {0.0f, 0.19509032201612825f, 0.38268343236508978f, 0.55557023301960218f, 0.70710678118654746f, 0.83146961230254524f, 0.92387953251128674f, 0.98078528040323043f,
                           1.0f, 0.98078528040323043f, 0.92387953251128674f, 0.83146961230254546f, 0.70710678118654757f, 0.55557023301960218f, 0.38268343236508989f, 0.19509032201612861f};
__device__ __forceinline__ f32x2 cmul(f32x2 a, f32x2 w) { return (f32x2){a.x * w.x - a.y * w.y, a.x * w.y + a.y * w.x}; }
template <int N> __device__ __forceinline__ void fft_dif(f32x2 (&v)[N]) {
#pragma unroll
    for (int len = N; len >= 2; len >>= 1) {
        const int half = len >> 1, step = 32 / len;
#pragma unroll
        for (int i = 0; i < N; i += len)
#pragma unroll
            for (int j = 0; j < half; ++j) {
                const f32x2 a = v[i + j], b = v[i + j + half]; v[i + j] = a + b; f32x2 d = a - b;
                const int ti = j * step;
                if (ti == 0) v[i + j + half] = d;
                else if (ti == 8) v[i + j + half] = (f32x2){d.y, -d.x};
                else v[i + j + half] = (f32x2){d.x * C32[ti] + d.y * S32[ti], d.y * C32[ti] - d.x * S32[ti]};
            }
    }
}
template <int BITS> __device__ __forceinline__ constexpr int brev(int x) { int r = 0; for (int i = 0; i < BITS; ++i) r |= ((x >> i) & 1) << (BITS - 1 - i); return r; }

__device__ __forceinline__ void fft_item(const Args& A, int item, LAS unsigned char* lds, int wv) {
    int tid = my_tid(wv); unsigned char* ws = A.ws;
    const bf16_t* U = (const bf16_t*)(ws + WS_U); bf16_t* AB = (bf16_t*)(ws + WS_ABUF); const f32x2* tw = (const f32x2*)(ws + WS_TW);
    const int b = item >> 7, g = (item >> 5) & 3, kp = item & 31;
    const bf16_t* zin = U + (size_t)b * SEQ * UP + 2048 + g * 128 + 4 * kp;
    LAS f32x2* L0 = (LAS f32x2*)lds; LAS f32x2* L1 = L0 + 256 * 33;
    __syncthreads();
    {
        f32x2 x0[16], x1[16];
#pragma unroll
        for (int na = 0; na < 16; ++na) { const u32x2 raw = *(const u32x2*)(zin + (size_t)(na * 512 + tid) * UP); x0[na] = (f32x2){bflo(raw.x), bfhi(raw.x)}; x1[na] = (f32x2){bflo(raw.y), bfhi(raw.y)}; }
        fft_dif<16>(x0); fft_dif<16>(x1);
        const int nb = tid >> 5, nc = tid & 31;
#pragma unroll
        for (int ka = 0; ka < 16; ++ka) { const f32x2 w = tw[(32 * nb * ka) & 8191]; const int idx = (ka * 16 + nb) * 33 + nc; L0[idx] = cmul(x0[brev<4>(ka)], w); L1[idx] = cmul(x1[brev<4>(ka)], w); }
    }
    f32x2 tw2[16];
    { const int ka = tid >> 5, nc = tid & 31;
#pragma unroll
      for (int kb = 0; kb < 16; ++kb) tw2[kb] = tw[(nc * (ka + 16 * kb)) & 8191]; }
    __syncthreads();
    {
        const int ka = tid >> 5, nc = tid & 31;
        f32x2 x0[16], x1[16];
#pragma unroll
        for (int nb = 0; nb < 16; ++nb) { const int idx = (ka * 16 + nb) * 33 + nc; x0[nb] = L0[idx]; x1[nb] = L1[idx]; }
        fft_dif<16>(x0); fft_dif<16>(x1);
#pragma unroll
        for (int kb = 0; kb < 16; ++kb) { const f32x2 w = tw2[kb]; const int idx = (ka * 16 + kb) * 33 + nc; L0[idx] = cmul(x0[brev<4>(kb)], w); L1[idx] = cmul(x1[brev<4>(kb)], w); }
    }
    __syncthreads();
    {
        LAS f32x2* L = (tid >> 8) ? L1 : L0; const int i2 = tid & 255;
        f32x2 x[32];
#pragma unroll
        for (int nc = 0; nc < 32; ++nc) x[nc] = L[i2 * 33 + nc];
        fft_dif<32>(x);
#pragma unroll
        for (int kc = 0; kc < 32; ++kc) L[i2 * 33 + kc] = x[brev<5>(kc)];
    }
    __syncthreads();
    bf16_t* orow = AB + (size_t)b * SEQ * AP + 1024 + g * 128;
#pragma unroll 4
    for (int pass = 0; pass < 16; ++pass) {
        const int kc = tid & 31, i2 = pass * 16 + (tid >> 5), ka = i2 >> 4, kb = i2 & 15;
        const int k = ka + 16 * kb + 256 * kc, km = (SEQ - k) & (SEQ - 1);
        const int im = ((km & 15) * 16 + ((km >> 4) & 15)) * 33 + (km >> 8);
        const f32x2 a0 = L0[i2 * 33 + kc], a1 = L1[i2 * 33 + kc], m0 = L0[im], m1 = L1[im];
        bf16_t* o = orow + (size_t)k * AP + 4 * kp;
        u32x2 w;
        if (kp == 0) { w.x = pk2(0.5f * (a0.x + m0.x), a1.x); w.y = pk2(m1.x, 0.5f * (a0.y + m0.y)); }
        else { w.x = pk2(a0.x, a1.x); w.y = pk2(m1.x, m0.x); }
        *(u32x2*)o = w;
    }
    __syncthreads();
}

#if FAST_GEMM
#define RUN_GEMM(g, S, E) gemm_phase<decltype(E), decltype(S), true, true>(lds, g, S, E, wv)
#define RUN_GEMM_T(g, S, E) gemm_phase<decltype(E), TailHalfOrder, true, true>(lds, g, S, E, wv)
#else
#define RUN_GEMM(g, S, E) gemm_phase_simple(lds, g, S, E, wv)
#define RUN_GEMM_T(g, S, E) gemm_phase_simple(lds, g, S, E, wv)
#endif
#define XB_TMO      128
#define XB_XCNT(j)  (256  + 64 * (j))
#define XB_XSUB(j)  (1280 + 64 * (j))
#define XB_XGEN(j)  (2304 + 64 * (j))
#define XB_TOP      3328
#define XB_TOPGEN   3392
#define XCD_BAR_WORDS 3456
#define XB_SPIN_CAP (1u << 22)
__device__ __forceinline__ unsigned xb_ld(unsigned* p)              { return __hip_atomic_load(p, __ATOMIC_RELAXED, __HIP_MEMORY_SCOPE_AGENT); }
__device__ __forceinline__ unsigned xb_add(unsigned* p, unsigned v) { return __hip_atomic_fetch_add(p, v, __ATOMIC_RELAXED, __HIP_MEMORY_SCOPE_AGENT); }
__device__ __forceinline__ unsigned xb_xcc_id() { return (unsigned)__builtin_amdgcn_s_getreg((3 << 11) | 20) & 0xFu; }
#define XB_SPIN(cond, bar) do { unsigned _sp = 0; while (cond) { __builtin_amdgcn_s_sleep(1); \
    if ((++_sp & 255u) == 0u) { if (xb_ld(&(bar)[XB_TMO])) break; if (_sp > XB_SPIN_CAP) { atomicAdd(&(bar)[XB_TMO], 1u); break; } } } } while (0)
struct XcdBarrier { unsigned* bar; unsigned x; volatile LAS unsigned* st; };
__device__ __forceinline__ XcdBarrier xcd_barrier_post(unsigned* bar, volatile LAS unsigned* st, bool leader) {
    XcdBarrier b; b.bar = bar; b.x = xb_xcc_id(); b.st = st;
    if (leader) (void)xb_add(&bar[XB_XCNT(b.x)], 1u);
    return b;
}
__device__ __forceinline__ void xcd_barrier_complete(unsigned* bar, unsigned x, int lane, volatile LAS unsigned* st) {
    const unsigned G = gridDim.x * gridDim.y * gridDim.z;
    unsigned c, sp = 0u;
    for (;;) {
        c = lane < 16 ? xb_ld(&bar[XB_XCNT(lane)]) : 0u;
        unsigned sum = c;
#pragma unroll
        for (int o = 1; o < 64; o <<= 1) sum += (unsigned)__builtin_amdgcn_ds_bpermute((lane ^ o) << 2, (int)sum);
        if (sum == G) break;
        __builtin_amdgcn_s_sleep(1);
        if ((++sp & 255u) == 0u) { if (__builtin_amdgcn_readfirstlane(xb_ld(&bar[XB_TMO]))) break; if (sp > XB_SPIN_CAP) { if (lane == 0) atomicAdd(&bar[XB_TMO], 1u); break; } }
    }
    const unsigned cnt = (unsigned)__builtin_popcountll(__ballot(c > 0u)), mine = (unsigned)__builtin_amdgcn_readlane((int)c, (int)x);
    if (lane == 0) { st[0] = mine > 0u ? mine : 1u; st[1] = cnt > 0u ? cnt : 1u; }
}
__device__ __forceinline__ void xcd_barrier(const XcdBarrier& b, int tid) {
    const bool leader = tid == 0;
    asm volatile("s_waitcnt vmcnt(0)" ::: "memory");
    __syncthreads();
    if (b.st[0] == 0u) {
        if (tid < 64) xcd_barrier_complete(b.bar, b.x, tid, b.st);
        __syncthreads();
    }
    if (leader) {
        unsigned* bar = b.bar;
        __builtin_amdgcn_s_waitcnt(0);
        const unsigned nloc = b.st[0], nx = b.st[1];
        const unsigned old = xb_add(&bar[XB_XSUB(b.x)], 1u);
        const unsigned gen = old / nloc;
        if (old + 1u == (gen + 1u) * nloc) {
            __builtin_amdgcn_fence(__ATOMIC_RELEASE, "agent");
            asm volatile("s_waitcnt vmcnt(0)" ::: "memory");
            const unsigned og = xb_add(&bar[XB_TOP], 1u);
            const unsigned tg = og / nx;
            if (og + 1u == (tg + 1u) * nx) {
#pragma unroll
                for (unsigned j = 0; j < 16; ++j) xb_add(&bar[XB_XGEN(j)], 1u);
                xb_add(&bar[XB_TOPGEN], 1u);
            } else XB_SPIN(xb_ld(&bar[XB_TOPGEN]) == tg, bar);
            __builtin_amdgcn_fence(__ATOMIC_ACQUIRE, "agent");
            asm volatile("s_waitcnt vmcnt(0)" ::: "memory");
        } else {
            XB_SPIN(xb_ld(&bar[XB_XGEN(b.x)]) == gen, bar);
            __builtin_amdgcn_fence(__ATOMIC_ACQUIRE, "agent");
            asm volatile("s_waitcnt vmcnt(0)" ::: "memory");
        }
    }
    __syncthreads();
}

__global__ void __launch_bounds__(NTHREADS, 2) fwd_kernel(Args A) {
    extern __shared__ __attribute__((aligned(16))) unsigned char lds_raw[];
    LAS unsigned char* lds = (LAS unsigned char*)lds_raw;
    cg::grid_group grid = cg::this_grid();
    const int wv = __builtin_amdgcn_readfirstlane(threadIdx.x >> 6);
    volatile LAS unsigned* bst = (volatile LAS unsigned*)(lds + LDS_BYTES - 16);
    if (threadIdx.x == 0) { bst[0] = 0u; bst[1] = 0u; }
    __syncthreads();
    const XcdBarrier xbar = xcd_barrier_post((unsigned*)(A.ws + WS_BAR), bst, threadIdx.x == 0);
    const int G = gridDim.x;
    for (int ph = A.ph_lo; ph < A.ph_hi; ++ph) {
        if (ph > A.ph_lo && ph % NPHASE != 3 && !(ph % NPHASE == 0 && MK_ONE_LAUNCH)) { if (ph < 0) grid.sync(); else xcd_barrier(xbar, my_tid(wv)); }
        unsigned char* ws = A.ws; asm volatile("" : "+s"(ws));
        int bid = blockIdx.x; asm volatile("" : "+s"(bid));
        bf16_t* XB = (bf16_t*)(ws + WS_XB); bf16_t* AB = (bf16_t*)(ws + WS_ABUF); bf16_t* UU = (bf16_t*)(ws + WS_U); bf16_t* MG = (bf16_t*)(ws + WS_MRG);
        float* ssqA = (float*)(ws + WS_SSQA); float* ssqB = (float*)(ws + WS_SSQB);
        const int layer = ph / NPHASE, p = ph % NPHASE;
        StaticOrder S;
        if (p == 0) {
            if (PHON(0)) p0_prep(A, layer, lds, G, wv);
        } else if (p == 1 && PHON(1)) {
            Gemm g{XB, (const bf16_t*)(ws + WS_WIN), M, NIN + NGATE, DM}; StaticOrderT<P1_WGM, 12> S; S.init(M, NIN + NGATE, G, bid);
            EpiInGate E{EpiIn{UU, ssqA, INP(A, I_QNG) + layer * 32, INP(A, I_KNG) + layer * 32, (const f32x2*)(ws + WS_ROPE)}, EpiGate{ws + WS_GATE, ssqA, INP(A, I_BGATE) + layer * NGATE}, ssqA};
            RUN_GEMM(g, S, E);
        } else if (p == 2) {
            const int vcu = (G % 8 == 0) ? (bid % 8) * (G / 8) + (bid / 8) : bid;
            if (PHON(8)) {
#if FAST_ATTN
                const float* gq = INP(A, I_QNG) + layer * 32; const float* gk = INP(A, I_KNG) + layer * 32;
                const int li = my_tid(wv) & 31;
                float gqm = fabsf(gq[li]), gkm = fabsf(gk[li]), d1 = INP(A, I_LQ1)[layer * 32 + li] * INP(A, I_LK1)[layer * 32 + li], d2 = INP(A, I_LQ2)[layer * 32 + li] * INP(A, I_LK2)[layer * 32 + li];
#pragma unroll
                for (int o = 1; o < 32; o <<= 1) { gqm = fmaxf(gqm, __shfl_xor(gqm, o)); gkm = fmaxf(gkm, __shfl_xor(gkm, o)); d1 += __shfl_xor(d1, o); d2 += __shfl_xor(d2, o); }
#define RFL_F(x) x = __builtin_bit_cast(float, __builtin_amdgcn_readfirstlane(__builtin_bit_cast(int, x)))
                RFL_F(gqm); RFL_F(gkm); RFL_F(d1); RFL_F(d2);
#undef RFL_F
                const float lam_init = 0.8f - 0.6f * expf(-0.3f * (float)layer), lam = expf(d1) - expf(d2) + lam_init, bound = QSCALE * 32.f * gqm * gkm;
                for (int u = vcu; u < 512; u += G) attn_unit_fast(A, layer, u, lds, bound, lam, lam_init, wv);
#else
                for (int u = blockIdx.x; u < 1024; u += G) attn_unit_ref(A, layer, u, lds, wv);
#endif
            }
            if (PHON(9)) for (int u = vcu; u < 256; u += G) conv_item(A, layer, u, lds, wv);
            if (PHON(10)) for (int u = vcu; u < 256; u += G) fft_item(A, u, lds, wv);
        } else if (p == 4 && PHON(4)) {
            Gemm g{AB, (const bf16_t*)(ws + WS_WM), M, DM, KMRG}; S.init(M, DM, G, bid);
            EpiMerge E{nullptr, ws + WS_GATE, MG};
            RUN_GEMM(g, S, E);
        } else if (p == 5 && PHON(5)) {
            Gemm g{MG, (const bf16_t*)(ws + WS_WO), M, DM, DM}; S.init(M, DM, G, bid);
            EpiRes<false> E{nullptr, XB, ssqB};
            RUN_GEMM(g, S, E);
        } else if (p == 6 && PHON(6)) {
            Gemm g{XB, (const bf16_t*)(ws + WS_WF1), M, NF1, DM}; TailHalfOrder T; T.init(M, NF1, G, bid);
            EpiFfnIn E{UU, ssqB};
            RUN_GEMM_T(g, T, E);
        } else if (p == 7 && PHON(7)) {
            Gemm g{UU, (const bf16_t*)(ws + ((layer & 1) ? WS_WF2B : WS_WF2)), M, DM, DFF}; S.init(M, DM, G, bid);
            if (layer == DEPTH - 1) { EpiRes<true> E{A.out, XB, ssqA}; RUN_GEMM(g, S, E); }
            else { EpiRes<false> E{nullptr, XB, ssqA}; RUN_GEMM(g, S, E); }
        }
    }
}

extern "C" void kernel_launch(void* const* d_in, const int* in_sizes, int n_in, void* d_out, int out_size, void* d_ws, size_t ws_size, hipStream_t stream) {
    static int grid = 0;
    if (grid == 0) {
        if (n_in != 23 || out_size != M * DM || ws_size < WS_END) { fprintf(stderr, "kernel_launch: unexpected shapes (n_in %d, out %d, ws %zu)\n", n_in, out_size, ws_size); grid = -1; return; }
        int dev = 0, cus = 0, per_cu = 0;
        (void)hipGetDevice(&dev); (void)hipDeviceGetAttribute(&cus, hipDeviceAttributeMultiprocessorCount, dev);
        (void)hipFuncSetAttribute((const void*)fwd_kernel, hipFuncAttributeMaxDynamicSharedMemorySize, LDS_BYTES);
        (void)hipOccupancyMaxActiveBlocksPerMultiprocessor(&per_cu, (const void*)fwd_kernel, NTHREADS, LDS_BYTES);
        if (per_cu < 1) { fprintf(stderr, "kernel_launch: occupancy query says %d blocks per CU\n", per_cu); per_cu = 1; }
        (void)hipGetLastError();
        grid = cus * per_cu;
    }
    if (grid < 0) return;
    (void)hipMemsetAsync((unsigned char*)d_ws + WS_BAR, 0, 16384, stream);
    Args a{};
    for (int i = 0; i < 23; ++i) a.in[i] = (const float*)d_in[i];
    a.out = (float*)d_out; a.ws = (unsigned char*)d_ws;
#if MK_ONE_LAUNCH
    a.ph_lo = 0; a.ph_hi = DEPTH * NPHASE;
    void* args[] = {&a};
    hipError_t e = hipLaunchCooperativeKernel((const void*)fwd_kernel, dim3(grid), dim3(NTHREADS), args, LDS_BYTES, stream);
    if (e != hipSuccess) fprintf(stderr, "cooperative launch failed: %s (grid %d)\n", hipGetErrorString(e), grid);
#else
    for (int ph = 0; ph < DEPTH * NPHASE; ++ph) { a.ph_lo = ph; a.ph_hi = ph + 1; hipLaunchKernelGGL(fwd_kernel, dim3(grid), dim3(NTHREADS), LDS_BYTES, stream, a); }
#endif
}
```

```cpp
#include <hip/hip_runtime.h>
#include <hip/hip_cooperative_groups.h>
#include <cstdio>
#include <cstdint>
namespace cg = cooperative_groups;

#ifndef PHMASK
#define PHMASK 0xFFFF
#endif
#define PHON(b) ((PHMASK >> (b)) & 1)
#ifndef FAST_GEMM
#define FAST_GEMM 1
#endif
#ifndef FAST_ATTN
#define FAST_ATTN 1
#endif
#ifndef MK_ONE_LAUNCH
#define MK_ONE_LAUNCH 1
#endif

#define LAS __attribute__((address_space(3)))
typedef unsigned short bf16_t;
typedef short bf16x8 __attribute__((ext_vector_type(8)));
typedef float f32x4 __attribute__((ext_vector_type(4)));
typedef float f32x2 __attribute__((ext_vector_type(2)));
typedef unsigned u32x4 __attribute__((ext_vector_type(4)));
typedef unsigned u32x2 __attribute__((ext_vector_type(2)));
typedef __bf16 bf16x2_t __attribute__((ext_vector_type(2)));

constexpr int BATCH = 2, SEQ = 8192, DM = 1024, M = BATCH * SEQ, DEPTH = 2;
constexpr int NH = 8, DFF = 2816, CONVW = 31;
constexpr int NIN = 3072, NGATE = 3072, KMRG = 1536, NF1 = 2 * DFF;
constexpr int UP = 2560;
constexpr int AP = 1536;
constexpr float EPS = 1e-6f;
constexpr float QSCALE = 0.17677669529663687f * 1.4426950408889634f;
constexpr int NTHREADS = 512, NWAVES = 8;
constexpr int LDS_BYTES = 147456;
constexpr int NPHASE = 8;

constexpr size_t MiB = 1u << 20;
constexpr size_t WS_ROPE = 0;
constexpr size_t WS_TW = 256 * 1024;
constexpr size_t WS_BAR = 512 * 1024;
constexpr size_t WS_SSQA = 1 * MiB;
constexpr size_t WS_SSQB = 2 * MiB;
constexpr size_t WS_WIN = 4 * MiB;
constexpr size_t WS_WG = 10 * MiB;
constexpr size_t WS_WM = 16 * MiB;
constexpr size_t WS_WO = 19 * MiB;
constexpr size_t WS_WF1 = 21 * MiB;
constexpr size_t WS_WF2 = 32 * MiB;
constexpr size_t WS_WF2B = 248 * MiB;
constexpr size_t WS_XB = 40 * MiB;
constexpr size_t WS_ABUF = 72 * MiB;
constexpr size_t WS_U = 120 * MiB;
constexpr size_t WS_MRG = WS_U;
constexpr size_t WS_GATE = 200 * MiB;
constexpr size_t WS_END = 254 * MiB;

__device__ __forceinline__ unsigned pk2(float lo, float hi) { f32x2 v = {lo, hi}; bf16x2_t b = __builtin_convertvector(v, bf16x2_t); return __builtin_bit_cast(unsigned, b); }
__device__ __forceinline__ float bflo(unsigned u) { return __uint_as_float(u << 16); }
__device__ __forceinline__ float bfhi(unsigned u) { return __uint_as_float(u & 0xffff0000u); }
__device__ __forceinline__ float bf1(bf16_t h) { return __uint_as_float((unsigned)h << 16); }
__device__ __forceinline__ bf16_t f2bf(float f) { return (bf16_t)(pk2(f, 0.f) & 0xffffu); }
__device__ __forceinline__ void store8(bf16_t* p, f32x4 a, f32x4 b) { u32x4 w; w.x = pk2(a[0], a[1]); w.y = pk2(a[2], a[3]); w.z = pk2(b[0], b[1]); w.w = pk2(b[2], b[3]); *(__attribute__((address_space(1))) u32x4*)p = w; }
__device__ __forceinline__ void load8(const bf16_t* p, f32x4& a, f32x4& b) { const u32x4 w = *(const __attribute__((address_space(1))) u32x4*)p; a = (f32x4){bflo(w.x), bfhi(w.x), bflo(w.y), bfhi(w.y)}; b = (f32x4){bflo(w.z), bfhi(w.z), bflo(w.w), bfhi(w.w)}; }
__device__ __forceinline__ float sigmoidf_(float x) { return __builtin_amdgcn_rcpf(1.f + __builtin_amdgcn_exp2f(-1.4426950408889634f * x)); }
__device__ __forceinline__ float row_rstd(const float* ssq, int r) {
    const f32x4* p = (const f32x4*)(ssq + (size_t)r * 16); const f32x4 a = p[0], b = p[1], c = p[2], d = p[3];
    const float s = ((a[0] + a[1]) + (a[2] + a[3])) + ((b[0] + b[1]) + (b[2] + b[3])) + ((c[0] + c[1]) + (c[2] + c[3])) + ((d[0] + d[1]) + (d[2] + d[3]));
    return __builtin_amdgcn_rsqf(s * (1.f / 1024.f) + EPS);
}
__device__ __forceinline__ float wave_sum(float v) {
#pragma unroll
    for (int o = 1; o < 64; o <<= 1) v += __shfl_xor(v, o);
    return v;
}
#define LDS_WAIT() asm volatile("s_waitcnt lgkmcnt(0)" ::: "memory")
__device__ __forceinline__ int my_tid(int w) {
    int l; asm volatile("v_mbcnt_lo_u32_b32 %0, -1, 0\n\tv_mbcnt_hi_u32_b32 %0, -1, %0" : "=v"(l) : "s"(w));
    return w * 64 + l;
}

constexpr int BM = 256, NXCD = 8, WGM = 2;
#define P1_WGM 4
struct Unit { int pm, pn, half; };
struct Gemm { const bf16_t* A; const bf16_t* Bt; int M, N, K; };
__device__ __forceinline__ int perm32(int rho) { const int n = rho >> 4, i = rho & 15; return 8 * (i >> 2) + 4 * n + (i & 3); }
template <int WGM_, int ROT_ = 0> struct StaticOrderT {
    static constexpr bool HALVES = false;
    int nM, nN, nwg, G, c;
    __device__ __forceinline__ void init(int M_, int N_, int G_, int c_) { nM = M_ / BM; nN = N_ / BM; nwg = nM * nN; G = G_; c = c_; }
    __device__ __forceinline__ void map(int wgid, Unit& u) const {
        { const int q = nwg / NXCD, r = nwg % NXCD, xcd = wgid % NXCD, off = wgid / NXCD; wgid = (xcd < r ? xcd * (q + 1) : r * (q + 1) + (xcd - r) * q) + off; }
        const int nig = WGM_ * nN, gid = wgid / nig, fm = gid * WGM_, gsz = (nM - fm) < WGM_ ? (nM - fm) : WGM_;
        u.pm = fm + ((wgid % nig) % gsz); u.pn = (wgid % nig) / gsz; if constexpr (ROT_ != 0) { u.pn += ROT_ * (gid & 1); if (u.pn >= nN) u.pn -= nN; }
    }
    __device__ __forceinline__ bool next(int i, Unit& u) const {
        const long L = (long)i * G + c; if (L >= nwg) return false;
        u.half = 0;
        int wgid = (int)L; { const int q = nwg / NXCD, r = nwg % NXCD, xcd = wgid % NXCD, off = wgid / NXCD; wgid = (xcd < r ? xcd * (q + 1) : r * (q + 1) + (xcd - r) * q) + off; }
        const int nig = WGM_ * nN, gid = wgid / nig, fm = gid * WGM_, gsz = (nM - fm) < WGM_ ? (nM - fm) : WGM_;
        u.pm = fm + ((wgid % nig) % gsz); u.pn = (wgid % nig) / gsz; if constexpr (ROT_ != 0) { u.pn += ROT_ * (gid & 1); if (u.pn >= nN) u.pn -= nN; } return true;
    }
};
using StaticOrder = StaticOrderT<WGM>;

struct TailHalfOrder : StaticOrder {
    static constexpr bool HALVES = true;
    __device__ __forceinline__ bool next(int i, Unit& u) const {
        const int rem = nwg % G, full = nwg / G;
        const bool tail = (2 * rem == G) && (i == full);
        const int L = tail ? full * G + (c % rem) : i * G + c;
        if (L >= nwg) return false;
        int pm_, pn_;
        { int wgid = L; const int q = nwg / NXCD, r = nwg % NXCD, xcd = wgid % NXCD, off = wgid / NXCD; wgid = (xcd < r ? xcd * (q + 1) : r * (q + 1) + (xcd - r) * q) + off;
          const int nig = WGM * nN, gid = wgid / nig, fm = gid * WGM, gsz = (nM - fm) < WGM ? (nM - fm) : WGM; pm_ = fm + ((wgid % nig) % gsz); pn_ = (wgid % nig) / gsz; }
        u.pm = pm_; u.pn = pn_; u.half = tail ? 1 + c / rem : 0; return true;
    }
};

#define FOR_AI_M _Pragma("unroll") for (int ai = 0; ai < 2; ++ai) _Pragma("unroll") for (int m = 0; m < 4; ++m)

template <class Epi>
__device__ __forceinline__ void gemm_phase_simple(LAS unsigned char* lds, const Gemm g, const StaticOrder& S, const Epi& E, int wv) {
    int tid = my_tid(wv);
    const int wid = __builtin_amdgcn_readfirstlane(tid >> 6), lane = tid & 63, wr = wid >> 2, wc = wid & 3, fr = lane & 15, fq = lane >> 4;
    const int K = g.K;
    Unit u;
    for (int i = 0; S.next(i, u); ++i) {
        f32x4 acc[2][2][4][2];
#pragma unroll
        for (int a = 0; a < 2; ++a)
#pragma unroll
            for (int b = 0; b < 2; ++b)
#pragma unroll
                for (int m = 0; m < 4; ++m)
#pragma unroll
                    for (int n = 0; n < 2; ++n) acc[a][b][m][n] = (f32x4){0.f, 0.f, 0.f, 0.f};
        const bf16_t* Ab = g.A + (size_t)(u.pm * BM + wr * 64 + fr) * K + fq * 8;
        const bf16_t* Bb = g.Bt + (size_t)(u.pn * BM + wc * 32) * K + fq * 8;
        const int p0 = perm32(fr), p1 = perm32(16 + fr);
        for (int k0 = 0; k0 < K; k0 += 32) {
            if constexpr (Epi::MID_K > 0) { if (k0 > 0 && (k0 % Epi::MID_K) == 0) E.mid(acc, u, k0 / Epi::MID_K - 1, wr, wc, fr, fq); }
            bf16x8 a[2][4], b[2][2];
#pragma unroll
            for (int ai = 0; ai < 2; ++ai)
#pragma unroll
                for (int m = 0; m < 4; ++m) a[ai][m] = *(const bf16x8*)(Ab + (size_t)(ai * 128 + m * 16) * K + k0);
#pragma unroll
            for (int bj = 0; bj < 2; ++bj) { b[bj][0] = *(const bf16x8*)(Bb + (size_t)(bj * 128 + p0) * K + k0); b[bj][1] = *(const bf16x8*)(Bb + (size_t)(bj * 128 + p1) * K + k0); }
#pragma unroll
            for (int ai = 0; ai < 2; ++ai)
#pragma unroll
                for (int bj = 0; bj < 2; ++bj)
#pragma unroll
                    for (int m = 0; m < 4; ++m)
#pragma unroll
                        for (int n = 0; n < 2; ++n) acc[ai][bj][m][n] = __builtin_amdgcn_mfma_f32_16x16x32_bf16(b[bj][n], a[ai][m], acc[ai][bj][m][n], 0, 0, 0);
        }
        LAS float* rtab = (LAS float*)(lds + 131072);
        if constexpr (Epi::NEED_RSTD) { __syncthreads(); if (tid < 256) rtab[tid] = row_rstd(E.ssq, u.pm * BM + tid); __syncthreads(); }
        E(acc, u, wr, wc, fr, fq, rtab);
    }
}

constexpr int BK = 64, HALF = 128, HTB = HALF * BK * 2, STAGE_BYTES = 8 * HTB;
__host__ __device__ __forceinline__ int lds_byte(int r, int c) { const int st = (r >> 4) * 2 + (c >> 5), rr = r & 15, cc = c & 31, ob = rr * 64 + cc * 2; return st * 1024 + (ob ^ (((ob >> 9) & 1) << 5)); }
__host__ __device__ __forceinline__ void stage_rc(int b, int& R, int& C) { const int st = b / 1024, sb = b % 1024, swz = sb ^ (((sb >> 9) & 1) << 5); R = (st >> 1) * 16 + swz / 64; C = (st & 1) * 32 + (swz % 64) / 2; }
template <class Epi, class Sched, bool ALIGN_EPI = false, bool SP2 = false>
__device__ __forceinline__ void gemm_phase(LAS unsigned char* lds, const Gemm g, const Sched& S, const Epi& E, int wv) {
    int tid = my_tid(wv);
    const int wid = __builtin_amdgcn_readfirstlane(tid >> 6), lane = tid & 63, wr = wid >> 2, wc = wid & 3, fr = lane & 15, fq = lane >> 4;
    const int K = g.K, nt = K / BK;
    unsigned voffA[2], voffB[2];
#pragma unroll
    for (int i = 0; i < 2; ++i) { int R, C; stage_rc(tid * 16 + i * 8192, R, C); const int Rb = (R & ~31) + perm32(R & 31);
        voffA[i] = (unsigned)(R * K + C) * 2u; voffB[i] = (unsigned)(Rb * K + C) * 2u; }
    const size_t kstep = (size_t)(BK * 2);
    const size_t hstep = (size_t)HALF * K * 2;
    const size_t tstep = 2 * hstep;
    const unsigned ldsw = (unsigned)wid * 1024u;
    const int aoff = lds_byte(wr * 64 + fr, fq * 8), boff = lds_byte(wc * 32 + fr, fq * 8);
#define PG8_SA(b, h) (((b) * 2 + (h)) * HTB)
#define PG8_SB(b, h) ((4 + (b) * 2 + (h)) * HTB)
#define PG8_STAGE(bufoff, gbase, voff) do { _Pragma("unroll") for (int _i = 0; _i < 2; ++_i) \
        __builtin_amdgcn_global_load_lds((const unsigned*)((const char*)(gbase) + (voff)[_i]), (LAS unsigned*)(lds + (bufoff) + ldsw + _i * 8192), 16, 0, 0); } while (0)
#define PG8_LDA(dst, b, h) do { _Pragma("unroll") for (int m = 0; m < 4; ++m) _Pragma("unroll") for (int k = 0; k < 2; ++k) dst[m][k] = *(const LAS bf16x8*)(lds + PG8_SA(b, h) + aoff + m * 2048 + k * 1024); } while (0)
#define PG8_LDB(dst, b, h) do { _Pragma("unroll") for (int n = 0; n < 2; ++n) _Pragma("unroll") for (int k = 0; k < 2; ++k) dst[n][k] = *(const LAS bf16x8*)(lds + PG8_SB(b, h) + boff + n * 2048 + k * 1024); } while (0)
#define PG8_MMA(ai, bj, At, Bt) do { __builtin_amdgcn_s_setprio(1); _Pragma("unroll") for (int m = 0; m < 4; ++m) _Pragma("unroll") for (int n = 0; n < 2; ++n) _Pragma("unroll") for (int k = 0; k < 2; ++k) \
        acc[ai][bj][m][n] = __builtin_amdgcn_mfma_f32_16x16x32_bf16(Bt[n][k], At[m][k], acc[ai][bj][m][n], 0, 0, 0); __builtin_amdgcn_s_setprio(0); } while (0)
#define PG8_WAIT_V(n) asm volatile("s_waitcnt vmcnt(" #n ")" ::: "memory")
#define PG8_WAIT_L(n) asm volatile("s_waitcnt lgkmcnt(" #n ")" ::: "memory")
#define PG8_BAR __builtin_amdgcn_s_barrier()
#define PG8_SCHED __builtin_amdgcn_sched_barrier(0)
    Unit cur, nxt; int ui = 0;
    if (!S.next(0, cur)) return;
    f32x4 acc[2][2][4][2];
#pragma unroll
    for (int a = 0; a < 2; ++a)
#pragma unroll
        for (int b = 0; b < 2; ++b)
#pragma unroll
            for (int m = 0; m < 4; ++m)
#pragma unroll
                for (int n = 0; n < 2; ++n) acc[a][b][m][n] = (f32x4){0.f, 0.f, 0.f, 0.f};
    bf16x8 At[4][2], B0[2][2], B1[2][2];
    const char* cA = (const char*)g.A + (size_t)cur.pm * tstep; const char* cB = (const char*)g.Bt + (size_t)cur.pn * tstep;
    if constexpr (SP2) {
        PG8_STAGE(PG8_SB(0, 0), cB, voffB); PG8_STAGE(PG8_SB(0, 1), cB + hstep, voffB); PG8_STAGE(PG8_SA(0, 0), cA, voffA); PG8_STAGE(PG8_SA(0, 1), cA + hstep, voffA);
        if (wr == 1) PG8_BAR;
        PG8_WAIT_V(2); PG8_BAR;
        PG8_STAGE(PG8_SB(1, 0), cB + kstep, voffB); PG8_STAGE(PG8_SA(1, 0), cA + kstep, voffA); PG8_STAGE(PG8_SB(1, 1), cB + hstep + kstep, voffB);
        PG8_WAIT_V(6); PG8_BAR;
    } else {
        PG8_STAGE(PG8_SB(0, 0), cB, voffB); PG8_STAGE(PG8_SA(0, 0), cA, voffA); PG8_STAGE(PG8_SB(0, 1), cB + hstep, voffB); PG8_STAGE(PG8_SA(0, 1), cA + hstep, voffA);
        if (wr == 1) PG8_BAR;
        PG8_WAIT_V(4); PG8_BAR;
        PG8_STAGE(PG8_SB(1, 0), cB + kstep, voffB); PG8_STAGE(PG8_SA(1, 0), cA + kstep, voffA); PG8_STAGE(PG8_SB(1, 1), cB + hstep + kstep, voffB);
        PG8_WAIT_V(6); PG8_BAR;
    }
    for (;;) {
        const bool has_next = S.next(ui + 1, nxt);
        const char* nA = has_next ? (const char*)g.A + (size_t)nxt.pm * tstep : cA; const char* nB = has_next ? (const char*)g.Bt + (size_t)nxt.pn * tstep : cB;
        for (int t = 0; t < nt; t += 2) {
            const bool last = (t == nt - 2);
            const char* a1 = cA + (size_t)(t + 1) * kstep;
            const char* a2 = last ? nA : cA + (size_t)(t + 2) * kstep; const char* b2 = last ? nB : cB + (size_t)(t + 2) * kstep;
            const char* a3 = a2 + kstep; const char* b3 = b2 + kstep;
            if constexpr (Epi::MID_K > 0) { if (t > 0 && (t * BK) % Epi::MID_K == 0) E.mid(acc, cur, (t * BK) / Epi::MID_K - 1, wr, wc, fr, fq); }
            if constexpr (SP2) {
            PG8_LDB(B0, 0, 0); PG8_LDB(B1, 0, 1); PG8_SCHED; PG8_LDA(At, 0, 0); PG8_STAGE(PG8_SA(1, 1), a1 + hstep, voffA);
            PG8_WAIT_V(8); PG8_WAIT_L(0); PG8_BAR; if (!Sched::HALVES || cur.half != 2) { PG8_MMA(0, 0, At, B0); PG8_MMA(0, 1, At, B1); } PG8_BAR; PG8_SCHED;
            PG8_LDA(At, 0, 1); PG8_STAGE(PG8_SB(0, 0), b2, voffB); PG8_STAGE(PG8_SB(0, 1), b2 + hstep, voffB); PG8_STAGE(PG8_SA(0, 0), a2, voffA);
            PG8_WAIT_V(8); PG8_WAIT_L(0); PG8_BAR; if (!Sched::HALVES || cur.half != 1) { PG8_MMA(1, 0, At, B0); PG8_MMA(1, 1, At, B1); } PG8_BAR; PG8_SCHED;
            PG8_LDB(B0, 1, 0); PG8_LDB(B1, 1, 1); PG8_SCHED; PG8_LDA(At, 1, 0); PG8_STAGE(PG8_SA(0, 1), a2 + hstep, voffA);
            PG8_WAIT_V(8); PG8_WAIT_L(0); PG8_BAR; if (!Sched::HALVES || cur.half != 2) { PG8_MMA(0, 0, At, B0); PG8_MMA(0, 1, At, B1); } PG8_BAR; PG8_SCHED;
            PG8_LDA(At, 1, 1); PG8_STAGE(PG8_SB(1, 0), b3, voffB); PG8_STAGE(PG8_SB(1, 1), b3 + hstep, voffB); PG8_STAGE(PG8_SA(1, 0), a3, voffA);
            PG8_WAIT_V(8); PG8_WAIT_L(0); PG8_BAR; if (!Sched::HALVES || cur.half != 1) { PG8_MMA(1, 0, At, B0); PG8_MMA(1, 1, At, B1); } PG8_BAR; PG8_SCHED;
            } else {
            PG8_LDB(B0, 0, 0); PG8_SCHED; PG8_LDA(At, 0, 0); PG8_STAGE(PG8_SA(1, 1), a1 + hstep, voffA);
            PG8_WAIT_L(8); PG8_BAR; PG8_WAIT_L(0); PG8_MMA(0, 0, At, B0); PG8_BAR; PG8_SCHED;
            PG8_LDB(B1, 0, 1); PG8_STAGE(PG8_SB(0, 0), b2, voffB);
            PG8_BAR; PG8_WAIT_L(0); PG8_MMA(0, 1, At, B1); PG8_BAR;
            PG8_LDA(At, 0, 1); PG8_STAGE(PG8_SA(0, 0), a2, voffA);
            PG8_BAR; PG8_WAIT_L(0); PG8_MMA(1, 0, At, B0); PG8_BAR; PG8_SCHED;
            PG8_STAGE(PG8_SB(0, 1), b2 + hstep, voffB);
            PG8_WAIT_V(6); PG8_BAR; PG8_MMA(1, 1, At, B1); PG8_BAR;
            PG8_LDB(B0, 1, 0); PG8_SCHED; PG8_LDA(At, 1, 0); PG8_STAGE(PG8_SA(0, 1), a2 + hstep, voffA);
            PG8_WAIT_L(8); PG8_BAR; PG8_WAIT_L(0); PG8_MMA(0, 0, At, B0); PG8_BAR; PG8_SCHED;
            PG8_LDB(B1, 1, 1); PG8_STAGE(PG8_SB(1, 0), b3, voffB);
            PG8_BAR; PG8_WAIT_L(0); PG8_MMA(0, 1, At, B1); PG8_BAR;
            PG8_LDA(At, 1, 1); PG8_STAGE(PG8_SA(1, 0), a3, voffA);
            PG8_BAR; PG8_WAIT_L(0); PG8_MMA(1, 0, At, B0); PG8_BAR; PG8_SCHED;
            PG8_STAGE(PG8_SB(1, 1), b3 + hstep, voffB);
            PG8_WAIT_V(6); PG8_BAR; PG8_MMA(1, 1, At, B1); PG8_BAR;
            }
        }
        if constexpr (ALIGN_EPI) { if (wr == 0) PG8_BAR; }
        LAS float* rtab = (LAS float*)(lds + STAGE_BYTES);
        if constexpr (Epi::NEED_RSTD) { if (tid < 256) rtab[tid] = row_rstd(E.ssq, cur.pm * BM + tid); asm volatile("s_waitcnt lgkmcnt(0)" ::: "memory"); PG8_BAR; asm volatile("" ::: "memory"); }
        E(acc, cur, wr, wc, fr, fq, rtab);
        if (!has_next) break;
#pragma unroll
        for (int a = 0; a < 2; ++a)
#pragma unroll
            for (int b = 0; b < 2; ++b)
#pragma unroll
                for (int m = 0; m < 4; ++m)
#pragma unroll
                    for (int n = 0; n < 2; ++n) acc[a][b][m][n] = (f32x4){0.f, 0.f, 0.f, 0.f};
        cur = nxt; cA = nA; cB = nB; ++ui;
        if constexpr (ALIGN_EPI) { if (wr == 1) PG8_BAR; }
    }
    PG8_WAIT_V(0);
    if constexpr (!ALIGN_EPI) { if (wr == 0) PG8_BAR; }
    PG8_BAR;
#undef PG8_SA
#undef PG8_SB
#undef PG8_STAGE
#undef PG8_LDA
#undef PG8_LDB
#undef PG8_MMA
#undef PG8_WAIT_V
#undef PG8_WAIT_L
#undef PG8_BAR
#undef PG8_SCHED
}

struct EpiIn {
    static constexpr int MID_K = 0; static constexpr bool NEED_RSTD = true;
    bf16_t* U; const float* ssq; const float* gq; const float* gk; const f32x2* rope;
    __device__ __forceinline__ void operator()(f32x4 (&acc)[2][2][4][2], const Unit& u, int wr, int wc, int fr, int fq, LAS const float* rtab) const {
        const int pn = u.pn;
        if (pn < 4) {
            typedef __attribute__((address_space(1))) f32x4 gf32x4;
            const float* gg = pn < 2 ? gq : gk; const float qs = pn < 2 ? QSCALE : 1.f;
            const f32x4 g0 = *(const gf32x4*)(gg + 8 * fq) * qs, g1 = *(const gf32x4*)(gg + 8 * fq + 4) * qs;
#pragma unroll
            for (int ai = 0; ai < 2; ++ai) {
                f32x4 cs[4][2];
#pragma unroll
                for (int m = 0; m < 4; ++m) { const int pos = (u.pm * BM + ai * 128 + wr * 64 + m * 16 + fr) & (SEQ - 1);
                    cs[m][0] = *(const gf32x4*)(rope + pos * 4); cs[m][1] = *(const gf32x4*)(rope + pos * 4 + 2); }
#pragma unroll
                for (int m = 0; m < 4; ++m) {
                    const int r = u.pm * BM + ai * 128 + wr * 64 + m * 16 + fr;
                    const float rs = rtab[ai * 128 + wr * 64 + m * 16 + fr];
                    bf16_t* urow = U + (size_t)r * UP;
#pragma unroll
                    for (int bj = 0; bj < 2; ++bj) {
                        f32x4 v0 = acc[ai][bj][m][0] * rs, v1 = acc[ai][bj][m][1] * rs;
                        float ss = (v0[0] * v0[0] + v0[1] * v0[1]) + (v0[2] * v0[2] + v0[3] * v0[3]) + (v1[0] * v1[0] + v1[1] * v1[1]) + (v1[2] * v1[2] + v1[3] * v1[3]);
                        ss += __shfl_xor(ss, 16); ss += __shfl_xor(ss, 32);
                        const float inv = __builtin_amdgcn_rsqf(ss * (1.f / 32.f) + EPS);
                        v0 = v0 * inv * g0; v1 = v1 * inv * g1;
                        if (fq == 0) {
#pragma unroll
                            for (int i = 0; i < 4; ++i) { const float c_ = cs[m][i >> 1][(i & 1) * 2], s_ = cs[m][i >> 1][(i & 1) * 2 + 1]; const float a = v0[i], b = v1[i]; v0[i] = a * c_ - b * s_; v1[i] = b * c_ + a * s_; }
                        }
                        store8(urow + pn * 256 + bj * 128 + wc * 32 + 8 * fq, v0, v1);
                    }
                }
            }
            return;
        }
        FOR_AI_M {
            const int r = u.pm * BM + ai * 128 + wr * 64 + m * 16 + fr;
            const float rs = rtab[ai * 128 + wr * 64 + m * 16 + fr];
            bf16_t* urow = U + (size_t)r * UP;
            if (pn < 6) {
#pragma unroll
                for (int bj = 0; bj < 2; ++bj) store8(urow + pn * 256 + bj * 128 + wc * 32 + 8 * fq, acc[ai][bj][m][0] * rs, acc[ai][bj][m][1] * rs);
            } else if (pn < 10) {
                f32x4 o[2];
                const float irs = __builtin_amdgcn_rcpf(rs);
#pragma unroll
                for (int n = 0; n < 2; ++n) { const f32x4 gb = acc[ai][1][m][n] * (rs * -1.4426950408889634f);
#pragma unroll
                    for (int j = 0; j < 4; ++j) o[n][j] = acc[ai][0][m][n][j] * __builtin_amdgcn_rcpf(__builtin_fmaf(__builtin_amdgcn_exp2f(gb[j]), irs, irs)); }
                store8(urow + 1536 + (pn - 6) * 128 + wc * 32 + 8 * fq, o[0], o[1]);
            } else {
#pragma unroll
                for (int bj = 0; bj < 2; ++bj) store8(urow + 2048 + (pn - 10) * 256 + bj * 128 + wc * 32 + 8 * fq, acc[ai][bj][m][0] * rs, acc[ai][bj][m][1] * rs);
            }
        }
    }
};
__device__ __forceinline__ size_t gates_off(int pm, int pn12, int wr, int wc, int e, int fr, int fq) { return ((((size_t)(pm * 12 + pn12) * 8 + (wr * 4 + wc)) * 16 + e) * 64 + (fq * 16 + fr)) * 8; }
typedef unsigned u32x2_t __attribute__((ext_vector_type(2)));
struct EpiGate {
    static constexpr int MID_K = 0; static constexpr bool NEED_RSTD = true;
    unsigned char* Gt; const float* ssq; const float* bias;
    __device__ __forceinline__ void operator()(f32x4 (&acc)[2][2][4][2], const Unit& u, int wr, int wc, int fr, int fq, LAS const float* rtab) const {
        const int c0 = u.pn * BM + wc * 32 + 8 * fq;
        typedef __attribute__((address_space(1))) f32x4 gf32x4;
        f32x4 bvn[2][2];
#pragma unroll
        for (int bj = 0; bj < 2; ++bj)
#pragma unroll
            for (int n = 0; n < 2; ++n) bvn[bj][n] = *(const gf32x4*)(bias + c0 + bj * 128 + 4 * n) * -1.4426950408889634f;
        FOR_AI_M {
            const int r = u.pm * BM + ai * 128 + wr * 64 + m * 16 + fr;
            const float rsn = rtab[ai * 128 + wr * 64 + m * 16 + fr] * -1.4426950408889634f;
#pragma unroll
            for (int bj = 0; bj < 2; ++bj) { u32x2_t w = {0u, 0u};
#pragma unroll
                for (int n = 0; n < 2; ++n) { const f32x4 bv = bvn[bj][n];
#pragma unroll
                    for (int j = 0; j < 4; ++j) {
                        const float e = __builtin_amdgcn_exp2f(acc[ai][bj][m][n][j] * rsn + bv[j]);
                        const float q = fmaxf(__builtin_amdgcn_rcpf(e * (1.f / 255.f) + (1.f / 255.f)), 1.f);
                        w[n] = __builtin_amdgcn_cvt_pk_u8_f32(q, j, w[n]); } }
                *(__attribute__((address_space(1))) u32x2_t*)(Gt + gates_off(u.pm, u.pn, wr, wc, ai * 8 + m * 2 + bj, fr, fq)) = w; }
        }
    }
};
struct EpiInGate {
    static constexpr int MID_K = 0; static constexpr bool NEED_RSTD = true;
    EpiIn a; EpiGate g; const float* ssq;
    __device__ __forceinline__ void operator()(f32x4 (&acc)[2][2][4][2], const Unit& u, int wr, int wc, int fr, int fq, LAS const float* rtab) const {
        if (u.pn < 12) a(acc, u, wr, wc, fr, fq, rtab);
        else { Unit v = u; v.pn = u.pn - 12; g(acc, v, wr, wc, fr, fq, rtab); }
    }
};
__device__ __forceinline__ void loadq8(const unsigned char* p, f32x4& a, f32x4& b) { const u32x2_t w = *(const u32x2_t*)p;
    a = (f32x4){(float)(w.x & 0xffu), (float)((w.x >> 8) & 0xffu), (float)((w.x >> 16) & 0xffu), (float)(w.x >> 24)};
    b = (f32x4){(float)(w.y & 0xffu), (float)((w.y >> 8) & 0xffu), (float)((w.y >> 16) & 0xffu), (float)(w.y >> 24)}; }
struct EpiMerge {
    static constexpr int MID_K = 512; static constexpr bool NEED_RSTD = false; const float* ssq;
    const unsigned char* Gt; bf16_t* Mg;
    __device__ __forceinline__ void mid(f32x4 (&acc)[2][2][4][2], const Unit& u, int seg, int wr, int wc, int fr, int fq) const {
        typedef __attribute__((address_space(1))) u32x2_t gu32x2;
#pragma unroll
        for (int ai = 0; ai < 2; ++ai) {
            u32x2_t qa[4][2], qb[4][2];
#pragma unroll
            for (int m = 0; m < 4; ++m)
#pragma unroll
                for (int bj = 0; bj < 2; ++bj) { const int e = ai * 8 + m * 2 + bj;
                    qa[m][bj] = *(const gu32x2*)(Gt + gates_off(u.pm, seg * 4 + u.pn, wr, wc, e, fr, fq)); qb[m][bj] = *(const gu32x2*)(Gt + gates_off(u.pm, (seg + 1) * 4 + u.pn, wr, wc, e, fr, fq)); }
#pragma unroll
            for (int m = 0; m < 4; ++m)
#pragma unroll
                for (int bj = 0; bj < 2; ++bj) { const u32x2_t wa = qa[m][bj], wb = qb[m][bj];
                    const f32x4 a0 = (f32x4){(float)(wa.x & 0xffu), (float)((wa.x >> 8) & 0xffu), (float)((wa.x >> 16) & 0xffu), (float)(wa.x >> 24)}, a1 = (f32x4){(float)(wa.y & 0xffu), (float)((wa.y >> 8) & 0xffu), (float)((wa.y >> 16) & 0xffu), (float)(wa.y >> 24)};
                    const f32x4 b0 = (f32x4){(float)(wb.x & 0xffu), (float)((wb.x >> 8) & 0xffu), (float)((wb.x >> 16) & 0xffu), (float)(wb.x >> 24)}, b1 = (f32x4){(float)(wb.y & 0xffu), (float)((wb.y >> 8) & 0xffu), (float)((wb.y >> 16) & 0xffu), (float)(wb.y >> 24)};
#pragma unroll
                    for (int j = 0; j < 4; ++j) { acc[ai][bj][m][0][j] *= a0[j] * __builtin_amdgcn_rcpf(b0[j]); acc[ai][bj][m][1][j] *= a1[j] * __builtin_amdgcn_rcpf(b1[j]); } }
        }
    }
    __device__ __forceinline__ void operator()(f32x4 (&acc)[2][2][4][2], const Unit& u, int wr, int wc, int fr, int fq, LAS const float* rtab) const {
        const int c0 = u.pn * BM + wc * 32 + 8 * fq;
        typedef __attribute__((address_space(1))) u32x2_t gu32x2;
#pragma unroll
        for (int ai = 0; ai < 2; ++ai) {
            u32x2_t gq[4][2];
#pragma unroll
            for (int m = 0; m < 4; ++m)
#pragma unroll
                for (int bj = 0; bj < 2; ++bj) gq[m][bj] = *(const gu32x2*)(Gt + gates_off(u.pm, 8 + u.pn, wr, wc, ai * 8 + m * 2 + bj, fr, fq));
#pragma unroll
            for (int m = 0; m < 4; ++m) {
                const int r = u.pm * BM + ai * 128 + wr * 64 + m * 16 + fr;
#pragma unroll
                for (int bj = 0; bj < 2; ++bj) { const u32x2_t w = gq[m][bj];
                    const f32x4 a0 = (f32x4){(float)(w.x & 0xffu), (float)((w.x >> 8) & 0xffu), (float)((w.x >> 16) & 0xffu), (float)(w.x >> 24)};
                    const f32x4 a1 = (f32x4){(float)(w.y & 0xffu), (float)((w.y >> 8) & 0xffu), (float)((w.y >> 16) & 0xffu), (float)(w.y >> 24)};
                    store8(Mg + (size_t)r * DM + c0 + bj * 128, acc[ai][bj][m][0] * (a0 * (1.f / 255.f)), acc[ai][bj][m][1] * (a1 * (1.f / 255.f))); }
            }
        }
    }
};
template <bool FINAL>
struct EpiRes {
    static constexpr int MID_K = 0; static constexpr bool NEED_RSTD = false;
    float* out; bf16_t* xb; float* ssq;
    __device__ __forceinline__ void operator()(f32x4 (&acc)[2][2][4][2], const Unit& u, int wr, int wc, int fr, int fq, LAS const float* rtab) const {
        typedef __attribute__((address_space(1))) u32x4 gu32x4;
        const int c0 = u.pn * BM + wc * 32 + 8 * fq;
#pragma unroll
        for (int ai = 0; ai < 2; ++ai) {
            u32x4 xr[4][2];
#pragma unroll
            for (int m = 0; m < 4; ++m)
#pragma unroll
                for (int bj = 0; bj < 2; ++bj) xr[m][bj] = *(const gu32x4*)(xb + (size_t)(u.pm * BM + ai * 128 + wr * 64 + m * 16 + fr) * DM + c0 + bj * 128);
#pragma unroll
            for (int m = 0; m < 4; ++m) {
                const int r = u.pm * BM + ai * 128 + wr * 64 + m * 16 + fr;
                float ss = 0.f;
#pragma unroll
                for (int bj = 0; bj < 2; ++bj) {
                    const size_t off = (size_t)r * DM + c0 + bj * 128;
                    const u32x4 w = xr[m][bj];
                    const f32x4 b0 = (f32x4){bflo(w.x), bfhi(w.x), bflo(w.y), bfhi(w.y)}, b1 = (f32x4){bflo(w.z), bfhi(w.z), bflo(w.w), bfhi(w.w)};
                    const f32x4 x0 = b0 + acc[ai][bj][m][0], x1 = b1 + acc[ai][bj][m][1];
                    if constexpr (FINAL) { *(f32x4*)(out + off) = x0; *(f32x4*)(out + off + 4) = x1; }
                    else store8(xb + off, x0, x1);
                    ss += (x0[0] * x0[0] + x0[1] * x0[1]) + (x0[2] * x0[2] + x0[3] * x0[3]) + (x1[0] * x1[0] + x1[1] * x1[1]) + (x1[2] * x1[2] + x1[3] * x1[3]);
                }
                ss += __shfl_xor(ss, 16); ss += __shfl_xor(ss, 32);
                if (!FINAL && fq == 0) ssq[(size_t)r * 16 + u.pn * 4 + wc] = ss;
            }
        }
    }
};
struct EpiFfnIn {
    static constexpr int MID_K = 0; static constexpr bool NEED_RSTD = true;
    bf16_t* HF; const float* ssq;
    __device__ __forceinline__ void operator()(f32x4 (&acc)[2][2][4][2], const Unit& u, int wr, int wc, int fr, int fq, LAS const float* rtab) const {
        FOR_AI_M {
            if (u.half && ai != u.half - 1) continue;
            const int r = u.pm * BM + ai * 128 + wr * 64 + m * 16 + fr;
            const float rs = rtab[ai * 128 + wr * 64 + m * 16 + fr];
            f32x4 o[2];
            const float irs2 = __builtin_amdgcn_rcpf(rs * rs);
#pragma unroll
            for (int n = 0; n < 2; ++n) { const f32x4 gt = acc[ai][0][m][n] * (rs * -1.4426950408889634f), gu = acc[ai][0][m][n] * acc[ai][1][m][n];
#pragma unroll
                for (int j = 0; j < 4; ++j) o[n][j] = gu[j] * __builtin_amdgcn_rcpf(__builtin_fmaf(__builtin_amdgcn_exp2f(gt[j]), irs2, irs2)); }
            store8(HF + (size_t)r * DFF + u.pn * 128 + wc * 32 + 8 * fq, o[0], o[1]);
        }
    }
};

struct Args { const float* in[23]; float* out; unsigned char* ws; int ph_lo, ph_hi; };
#define INP(A, k) ({ int i_ = (k); asm volatile("" : "+s"(i_)); (A).in[i_]; })
enum { I_X = 0, I_N1G, I_WIN, I_QNG, I_KNG, I_LQ1, I_LK1, I_LQ2, I_LK2, I_SUBG, I_WPA, I_CW, I_CB, I_CLG, I_CLB, I_WPB, I_WPC, I_WGATE, I_BGATE, I_WOUT, I_N2G, I_WF1, I_WF2 };

__device__ __forceinline__ int fperm(int kx) {
    const int g = kx >> 7, kp = (kx & 127) >> 2, i = kx & 3;
    const int col = kp == 0 ? (i == 0 ? 0 : (i == 1 ? 1 : (i == 2 ? 127 : 64))) : (i == 0 ? 2 * kp : (i == 1 ? 2 * kp + 1 : (i == 2 ? 127 - 2 * kp : 128 - 2 * kp)));
    return g * 128 + col;
}
__device__ __forceinline__ void tr_item(const float* W, int ldw, int srccol, const float* rowscale, bf16_t* WT, int ldk, int koff, int k0, int n0, LAS float* scr, int lane, bool rowperm = false) {
    float tv[32];
#pragma unroll
    for (int i = 0; i < 32; ++i) { const int kk = 2 * i + (lane >> 5); const int kx = rowperm ? fperm(k0 + kk) : k0 + kk; tv[i] = __builtin_nontemporal_load(W + (size_t)kx * ldw + srccol + (lane & 31)); }
    const int c = lane & 7;
    f32x4 rs0 = {1.f, 1.f, 1.f, 1.f}, rs1 = {1.f, 1.f, 1.f, 1.f};
    if (rowscale) { rs0 = *(const f32x4*)(rowscale + k0 + 8 * c); rs1 = *(const f32x4*)(rowscale + k0 + 8 * c + 4); }
#pragma unroll
    for (int i = 0; i < 32; ++i) { const int kk = 2 * i + (lane >> 5); scr[kk * 33 + (lane & 31)] = tv[i]; }
    LDS_WAIT();
#pragma unroll
    for (int j = 0; j < 4; ++j) { const int n = (lane >> 3) + 8 * j; const LAS float* s = scr + (8 * c) * 33 + n;
        u32x4 o; o.x = pk2(s[0 * 33] * rs0[0], s[1 * 33] * rs0[1]); o.y = pk2(s[2 * 33] * rs0[2], s[3 * 33] * rs0[3]); o.z = pk2(s[4 * 33] * rs1[0], s[5 * 33] * rs1[1]); o.w = pk2(s[6 * 33] * rs1[2], s[7 * 33] * rs1[3]);
        *(u32x4*)(WT + (size_t)(n0 + n) * ldk + koff + k0 + 8 * c) = o; }
    LDS_WAIT();
}

constexpr int PI_A = 16 * 80, PI_B = 16 * 96, PI_C = 3 * 8 * 32, PI_D = 16 * 32, PI_E = 16 * 176, PI_F = 44 * 32, PI_EARLY = PI_A + PI_B, PI_LATE = PI_C + PI_D + PI_E + PI_F, PI_ALL = PI_EARLY + PI_LATE;
__device__ __forceinline__ void prep_item(const Args& A, int layer, int it, LAS float* scr, int lane) {
    unsigned char* ws = A.ws;
    const float* n1g = INP(A, I_N1G) + layer * DM; const float* n2g = INP(A, I_N2G) + layer * DM;
    int r = it;
    if (r < PI_A) { const int kb = r / 80, nb = r % 80, n0 = nb * 32; int src = n0;
        if (n0 >= 1536) { const int t = (n0 - 1536) >> 8, w = (n0 - 1536) & 255; src = 1536 + (w >> 7) * 512 + t * 128 + (w & 127); }
        tr_item(INP(A, I_WIN) + (size_t)layer * DM * NIN, NIN, src, n1g, (bf16_t*)(ws + WS_WIN), DM, 0, kb * 64, n0, scr, lane); return; } r -= PI_A;
    if (r < PI_B) { const int kb = r / 96, nb = r % 96; tr_item(INP(A, I_WGATE) + (size_t)layer * DM * NGATE, NGATE, nb * 32, n1g, (bf16_t*)(ws + WS_WG), DM, 0, kb * 64, nb * 32, scr, lane); return; } r -= PI_B;
    if (r < PI_C) { const int br = r / 256, q = r % 256, kb = q / 32, nb = q % 32; const float* W = (br == 0 ? INP(A, I_WPA) : (br == 1 ? INP(A, I_WPB) : INP(A, I_WPC))) + (size_t)layer * 512 * DM;
        tr_item(W, DM, nb * 32, nullptr, (bf16_t*)(ws + WS_WM), KMRG, br * 512, kb * 64, nb * 32, scr, lane, br == 2); return; } r -= PI_C;
    if (r < PI_D) { const int kb = r / 32, nb = r % 32; tr_item(INP(A, I_WOUT) + (size_t)layer * DM * DM, DM, nb * 32, nullptr, (bf16_t*)(ws + WS_WO), DM, 0, kb * 64, nb * 32, scr, lane); return; } r -= PI_D;
    if (r < PI_E) { const int kb = r / 176, nb = r % 176, n0 = nb * 32; const int t = n0 >> 8, w = n0 & 255; const int src = (w >> 7) * DFF + t * 128 + (w & 127);
        tr_item(INP(A, I_WF1) + (size_t)layer * DM * NF1, NF1, src, n2g, (bf16_t*)(ws + WS_WF1), DM, 0, kb * 64, n0, scr, lane); return; } r -= PI_E;
    { const int kb = r / 32, nb = r % 32; tr_item(INP(A, I_WF2) + (size_t)layer * DFF * DM, DM, nb * 32, nullptr, (bf16_t*)(ws + ((layer & 1) ? WS_WF2B : WS_WF2)), DFF, 0, kb * 64, nb * 32, scr, lane); }
}
constexpr int PI_FOLD = DM * 4;
__device__ __forceinline__ void fold_task(const Args& A, int layer, int it, LAS const f32x2* cs128, int lane) {
    const float* w_in = INP(A, I_WIN) + (size_t)layer * DM * NIN; const float* n1g = INP(A, I_N1G) + layer * DM; bf16_t* Win_t = (bf16_t*)(A.ws + WS_WIN);
    const int k = __builtin_amdgcn_readfirstlane(it >> 2), g = __builtin_amdgcn_readfirstlane(it & 3);
    const float* wr_ = w_in + (size_t)k * NIN + 2560 + g * 128;
    const int j0 = lane, j1 = lane + 64; float s0 = 0.f, s1 = 0.f;
    const f32x2 r0 = cs128[j0 == 1 ? 64 : (j0 >> 1)], r1 = cs128[j1 >> 1];
    const bool sn0 = (j0 & 1) && j0 != 1, sn1 = (j1 & 1);
    float x0 = sn0 ? 0.f : 1.f, y0 = sn0 ? 1.f : 0.f, x1 = sn1 ? 0.f : 1.f, y1 = sn1 ? 1.f : 0.f;
#pragma unroll 16
    for (int c = 0; c < 128; ++c) { const float wv_ = wr_[c];
        s0 += wv_ * x0; s1 += wv_ * x1;
        const float nx0 = x0 * r0.x - y0 * r0.y, ny0 = x0 * r0.y + y0 * r0.x, nx1 = x1 * r1.x - y1 * r1.y, ny1 = x1 * r1.y + y1 * r1.x;
        x0 = nx0; y0 = ny0; x1 = nx1; y1 = ny1; }
    const float sc = n1g[k] * (1.f / 1024.f);
    Win_t[(size_t)(2560 + g * 128 + j0) * DM + k] = f2bf(s0 * sc); Win_t[(size_t)(2560 + g * 128 + j1) * DM + k] = f2bf(s1 * sc);
}

__device__ __forceinline__ void p0_prep(const Args& A, int layer, LAS unsigned char* lds, int G, int wv, bool all) {
    int tid = my_tid(wv);
    const int lane = tid & 63, wave = __builtin_amdgcn_readfirstlane(tid >> 6);
    unsigned char* ws = A.ws;
    LAS float* scr = (LAS float*)(lds + wave * 16384);
    LAS f32x2* cs128 = (LAS f32x2*)(lds + 8 * 16384);
    if (tid < 128) { float s, c; sincospif((float)tid * (1.f / 64.f), &s, &c); cs128[tid] = (f32x2){c, s}; }
    __syncthreads();
    const int gw = blockIdx.x * NWAVES + wave, NGW = G * NWAVES;
    for (int it = gw; it < (all ? PI_ALL : PI_EARLY); it += NGW) prep_item(A, layer, it, scr, lane);
    for (int it = gw; it < PI_FOLD; it += NGW) fold_task(A, layer, it, cs128, lane);
    if (layer == 0) {
        const float* x = INP(A, I_X); bf16_t* XB = (bf16_t*)(ws + WS_XB); float* ssq = (float*)(ws + WS_SSQA);
        for (int m0 = gw * 2; m0 < M; m0 += NGW * 2) {
            f32x4 v[2][4];
#pragma unroll
            for (int rr = 0; rr < 2; ++rr) { const f32x4* xr = (const f32x4*)(x + (size_t)(m0 + rr) * DM) + lane;
#pragma unroll
                for (int j = 0; j < 4; ++j) v[rr][j] = xr[64 * j]; }
#pragma unroll
            for (int rr = 0; rr < 2; ++rr) { u32x2* o8 = (u32x2*)(XB + (size_t)(m0 + rr) * DM) + lane; float s = 0.f;
#pragma unroll
                for (int j = 0; j < 4; ++j) { const f32x4 w = v[rr][j]; s += (w[0] * w[0] + w[1] * w[1]) + (w[2] * w[2] + w[3] * w[3]); o8[64 * j] = (u32x2){pk2(w[0], w[1]), pk2(w[2], w[3])}; }
                s = wave_sum(s);
                if (lane < 16) ssq[(size_t)(m0 + rr) * 16 + lane] = lane == 0 ? s : 0.f; }
        }
        f32x2* rope = (f32x2*)(ws + WS_ROPE); f32x2* tw = (f32x2*)(ws + WS_TW);
        for (int o = blockIdx.x * NTHREADS + tid; o < SEQ * 4; o += G * NTHREADS) {
            const int pos = o >> 2, i = o & 3; const float inv = i == 0 ? 1.0f : (i == 1 ? 0.037606031f : (i == 2 ? 0.0014142136f : 5.3183104e-05f));
            const float ang = (float)pos * inv; double t = (double)ang * 0.15915494309189535; t -= __builtin_rint(t); float s, c; sincospif((float)(2.0 * t), &s, &c); rope[o] = (f32x2){c, s};
        }
        for (int o = blockIdx.x * NTHREADS + tid; o < SEQ; o += G * NTHREADS) { float s, c; sincospif((float)o * (1.f / 4096.f), &s, &c); tw[o] = (f32x2){c, -s}; }
    }
}

__device__ __forceinline__ void attn_unit_ref(const Args& A, int layer, int unit, LAS unsigned char* lds, int wv) {
    int tid = my_tid(wv); unsigned char* ws = A.ws;
    const bf16_t* U = (const bf16_t*)(ws + WS_U); bf16_t* AB = (bf16_t*)(ws + WS_ABUF);
    const int b = unit >> 9, h = (unit >> 6) & 7, qb = unit & 63;
    const int qrow = tid & 127, comp = (tid >> 7) & 1, dh = tid >> 8;
    const float* gq = INP(A, I_QNG) + layer * 32; const float* gk = INP(A, I_KNG) + layer * 32;
    float gqm = 0.f, gkm = 0.f;
    for (int i = 0; i < 32; ++i) { gqm = fmaxf(gqm, fabsf(gq[i])); gkm = fmaxf(gkm, fabsf(gk[i])); }
    const float bound = QSCALE * 32.f * gqm * gkm;
    float d1 = 0.f, d2 = 0.f;
    for (int i = 0; i < 32; ++i) { d1 += INP(A, I_LQ1)[layer * 32 + i] * INP(A, I_LK1)[layer * 32 + i]; d2 += INP(A, I_LQ2)[layer * 32 + i] * INP(A, I_LK2)[layer * 32 + i]; }
    const float lam_init = 0.8f - 0.6f * expf(-0.3f * (float)layer);
    const float lam = expf(d1) - expf(d2) + lam_init;
    LAS float* Kt = (LAS float*)lds;
    LAS float* Vt = Kt + 64 * 64;
    const size_t tok0 = (size_t)b * SEQ;
    float q[32];
    { const bf16_t* qp = U + (tok0 + qb * 128 + qrow) * UP + h * 64 + comp * 32;
#pragma unroll
      for (int i = 0; i < 4; ++i) { f32x4 a0, a1; load8(qp + 8 * i, a0, a1);
#pragma unroll
          for (int j = 0; j < 4; ++j) { q[8 * i + j] = a0[j]; q[8 * i + 4 + j] = a1[j]; } } }
    float o[32]; float l = 0.f;
#pragma unroll
    for (int i = 0; i < 32; ++i) o[i] = 0.f;
    for (int kt = 0; kt < SEQ / 64; ++kt) {
        __syncthreads();
        { const int row = tid >> 3, ch = tid & 7; const bf16_t* kp = U + (tok0 + kt * 64 + row) * UP + 512 + h * 64 + ch * 8; const bf16_t* vp = U + (tok0 + kt * 64 + row) * UP + 1024 + h * 64 + ch * 8;
          f32x4 a0, a1; load8(kp, a0, a1); *(LAS f32x4*)(Kt + row * 64 + ch * 8) = a0; *(LAS f32x4*)(Kt + row * 64 + ch * 8 + 4) = a1;
          load8(vp, a0, a1); *(LAS f32x4*)(Vt + row * 64 + ch * 8) = a0; *(LAS f32x4*)(Vt + row * 64 + ch * 8 + 4) = a1; }
        __syncthreads();
#pragma unroll 1
        for (int kk = 0; kk < 64; ++kk) {
            const LAS float* kr = Kt + kk * 64 + comp * 32; float s = 0.f;
#pragma unroll
            for (int d = 0; d < 32; d += 4) { const f32x4 kv = *(const LAS f32x4*)(kr + d); s += q[d] * kv[0] + q[d + 1] * kv[1] + q[d + 2] * kv[2] + q[d + 3] * kv[3]; }
            const float e = exp2f(s - bound); l += e;
            const LAS float* vr = Vt + kk * 64 + dh * 32;
#pragma unroll
            for (int d = 0; d < 32; d += 4) { const f32x4 vv = *(const LAS f32x4*)(vr + d); o[d] += e * vv[0]; o[d + 1] += e * vv[1]; o[d + 2] += e * vv[2]; o[d + 3] += e * vv[3]; }
        }
    }
    __syncthreads();
    LAS float* X = (LAS float*)lds;
    const float il = 1.f / l;
    if (comp == 0) {
#pragma unroll
        for (int d = 0; d < 32; ++d) X[qrow * 65 + dh * 32 + d] = o[d] * il;
    }
    __syncthreads();
    if (comp == 1) {
#pragma unroll
        for (int d = 0; d < 32; ++d) X[qrow * 65 + dh * 32 + d] -= lam * o[d] * il;
    }
    __syncthreads();
    if (tid < 128) {
        const float* sg = INP(A, I_SUBG) + layer * 64; float ss = 0.f;
#pragma unroll 8
        for (int d = 0; d < 64; ++d) { const float v = X[tid * 65 + d]; ss += v * v; }
        const float inv = (1.f - lam_init) / sqrtf(ss * (1.f / 64.f) + EPS);
        bf16_t* op = AB + (tok0 + qb * 128 + tid) * AP + h * 64;
#pragma unroll 2
        for (int i = 0; i < 8; ++i) { f32x4 a0, a1;
#pragma unroll
            for (int j = 0; j < 4; ++j) { a0[j] = X[tid * 65 + 8 * i + j] * inv * sg[8 * i + j]; a1[j] = X[tid * 65 + 8 * i + 4 + j] * inv * sg[8 * i + 4 + j]; }
            store8(op + 8 * i, a0, a1); }
    }
    __syncthreads();
}

typedef float f32x16 __attribute__((ext_vector_type(16)));
typedef short s16x4 __attribute__((ext_vector_type(4)));
typedef short v4i16_t __attribute__((ext_vector_type(4)));
constexpr int AK_ROWB = 144, AK_BYTES = 64 * AK_ROWB, AV_BYTES = 8192;
constexpr int ARING = 5;
constexpr int ALDS_K = 0, ALDS_V = ARING * AK_BYTES, ALDS_WS = ALDS_V + ARING * AV_BYTES, ALDS_STG = 0, ASTG_ROW = 68, ASTG_BYTES = 32 * ASTG_ROW * 4, ALDS_END = ALDS_WS + NWAVES * 256;
static_assert(NWAVES * ASTG_BYTES <= ALDS_WS, "attention output stage overlays the K/V rings only");
static_assert(ALDS_END <= LDS_BYTES, "attention LDS map");
__device__ __forceinline__ int crow(int r, int hi) { return (r & 3) + 8 * (r >> 2) + 4 * hi; }
__device__ __forceinline__ s16x4 vtr(LAS const unsigned char* p) { return __builtin_bit_cast(s16x4, __builtin_amdgcn_ds_read_tr16_b64_v4i16((LAS v4i16_t*)p)); }

#define SBAR() __builtin_amdgcn_sched_barrier(0)
__device__ __forceinline__ bf16x8 kfrag(LAS const unsigned char* kb, int Gq) {
    return *(LAS const bf16x8*)(kb + (Gq < 4 ? 1 : 0) * 32 * AK_ROWB + (4 * (Gq & 1) + 2 * ((Gq >> 1) & 1)) * 16); }
template <int G>
__device__ __forceinline__ void attn_hgroup(f32x16 (&o)[2][2], f32x16 (&S)[2][2], u32x4 (&PW)[2][4], s16x4 (&vl)[4], s16x4 (&vh)[4], bf16x8 (&kf)[4], const bf16x8 (&qr)[2][2],
                                            LAS const unsigned char* vb, LAS const unsigned char* vbn, LAS const unsigned char* kbA, LAS const unsigned char* kbB,
                                            f32x4& la, f32x4& lb, const bf16x8& sel, const f32x16& zero16) {
    constexpr int c = G & 1, ks = G >> 1, hf = ks >> 1, s_ = ks & 1, PB = G < 4 ? 2 : 0;
    if constexpr (c == 0) { constexpr int kn = (ks + 1) & 3; LAS const unsigned char* vp = ks == 3 ? vbn : vb;
#pragma unroll
        for (int d0 = 0; d0 < 2; ++d0) { vl[(kn & 1) * 2 + d0] = vtr(vp + d0 * 4096 + kn * 1024); vh[(kn & 1) * 2 + d0] = vtr(vp + d0 * 4096 + kn * 1024 + 512); } }
    kf[(G + 2) & 3] = kfrag(G < 2 ? kbA : kbB, (G + 2) & 7);
    const bf16x8 pa = __builtin_bit_cast(bf16x8, PW[c][ks]);
    const s16x4 v0l = vl[(ks & 1) * 2], v0h = vh[(ks & 1) * 2], v1l = vl[(ks & 1) * 2 + 1], v1h = vh[(ks & 1) * 2 + 1];
    const bf16x8 vf0 = (bf16x8){v0l[0], v0l[1], v0l[2], v0l[3], v0h[0], v0h[1], v0h[2], v0h[3]}, vf1 = (bf16x8){v1l[0], v1l[1], v1l[2], v1l[3], v1h[0], v1h[1], v1h[2], v1h[3]};
    float e[8];
    __builtin_amdgcn_s_setprio(PB + 1); SBAR(); o[c][0] = __builtin_amdgcn_mfma_f32_32x32x16_bf16(pa, vf0, o[c][0], 0, 0, 0);
#pragma unroll
    for (int j = 0; j < 3; ++j) e[j] = __builtin_amdgcn_exp2f(S[c][hf][8 * s_ + j]);
    asm volatile("" : "+v"(e[0]), "+v"(e[1]), "+v"(e[2]));
    SBAR();
    o[c][1] = __builtin_amdgcn_mfma_f32_32x32x16_bf16(pa, vf1, o[c][1], 0, 0, 0);
#pragma unroll
    for (int j = 3; j < 6; ++j) e[j] = __builtin_amdgcn_exp2f(S[c][hf][8 * s_ + j]);
    asm volatile("" : "+v"(e[3]), "+v"(e[4]), "+v"(e[5]));
    SBAR();
    if constexpr (c == 0) { la = __builtin_amdgcn_mfma_f32_16x16x32_bf16(pa, sel, la, 0, 0, 0); asm volatile("" : "+v"(la)); }
    else { lb = __builtin_amdgcn_mfma_f32_16x16x32_bf16(pa, sel, lb, 0, 0, 0); asm volatile("" : "+v"(lb)); }
    e[6] = __builtin_amdgcn_exp2f(S[c][hf][8 * s_ + 6]);
    asm volatile("" : "+v"(e[6]));
    SBAR();
    { constexpr int qc = G & 1, qk = (G >> 1) & 1, qh = G < 4 ? 1 : 0;
      if constexpr (qk == 0) S[qc][qh] = __builtin_amdgcn_mfma_f32_32x32x16_bf16(kf[G & 3], qr[qc][0], zero16, 0, 0, 0);
      else S[qc][qh] = __builtin_amdgcn_mfma_f32_32x32x16_bf16(kf[G & 3], qr[qc][1], S[qc][qh], 0, 0, 0);
      __builtin_amdgcn_s_setprio(PB); }
    e[7] = __builtin_amdgcn_exp2f(S[c][hf][8 * s_ + 7]);
    PW[c][ks] = (u32x4){pk2(e[0], e[1]), pk2(e[2], e[3]), pk2(e[4], e[5]), pk2(e[6], e[7])};
    asm volatile("" : "+v"(PW[c][ks]));
    SBAR();
}

__device__ __forceinline__ void attn_preload(const Args& A, int un, int wv, u32x4 (&pre)[13]) {
    typedef __attribute__((address_space(1))) u32x4 gu32x4_;
    const int tid = my_tid(wv), lane = tid & 63, r32 = lane & 31, hi = lane >> 5, wid = __builtin_amdgcn_readfirstlane(tid >> 6), srow = tid >> 3, sch = tid & 7;
    const bf16_t* U = (const bf16_t*)(A.ws + WS_U);
    const int b_ = un >> 8, h_ = (un >> 5) & 7, qb_ = un & 31; const size_t tk_ = (size_t)b_ * SEQ;
    const bf16_t* qp_ = U + (tk_ + qb_ * 256 + wid * 32 + r32) * UP + h_ * 64 + hi * 8;
    const bf16_t* kg_ = U + (tk_ + srow) * UP + 512 + h_ * 64 + sch * 8; const bf16_t* vg_ = kg_ + 512;
#pragma unroll
    for (int i_ = 0; i_ < 4; ++i_) pre[i_] = *(const gu32x4_*)(qp_ + (i_ >> 1) * 32 + (i_ & 1) * 16);
#pragma unroll
    for (int i_ = 0; i_ < 4; ++i_) pre[4 + i_] = *(const gu32x4_*)(kg_ + (size_t)i_ * 64 * UP);
#pragma unroll
    for (int i_ = 0; i_ < 3; ++i_) pre[8 + i_] = *(const gu32x4_*)(vg_ + (size_t)i_ * 64 * UP);
    pre[11] = *(const gu32x4_*)(kg_ + (size_t)4 * 64 * UP); pre[12] = *(const gu32x4_*)(vg_ + (size_t)3 * 64 * UP);
}
__device__ __forceinline__ void attn_unit_fast(const Args& A, int layer, int unit, int next_unit, LAS unsigned char* lds, float bound, float lam, float lam_init, int wv, u32x4 (&pre)[13]) {
    int tid = my_tid(wv); unsigned char* ws = A.ws;
    const int lane = tid & 63, r32 = lane & 31, hi = lane >> 5, wid = __builtin_amdgcn_readfirstlane(tid >> 6);
    const bf16_t* U = (const bf16_t*)(ws + WS_U); bf16_t* AB = (bf16_t*)(ws + WS_ABUF);
    const int b = unit >> 8, h = (unit >> 5) & 7, qb = unit & 31;
    const size_t tok0 = (size_t)b * SEQ; const int q0 = qb * 256 + wid * 32;
    const int srow = tid >> 3, sch = tid & 7;
    const bf16_t* kg = U + (tok0 + srow) * UP + 512 + h * 64 + sch * 8;
    const bf16_t* vg = U + (tok0 + srow) * UP + 1024 + h * 64 + sch * 8;
        const unsigned char* kgb = (const unsigned char*)(U + tok0 * UP + 512 + h * 64);
    const unsigned gvo = (unsigned)(srow * UP + sch * 8) * 2u;
    const __amdgpu_buffer_rsrc_t kvrs = __builtin_amdgcn_make_buffer_rsrc((void*)kgb, 0, 0x7fffffff, 0x00020000);
#define KTILE(j) __builtin_amdgcn_raw_buffer_load_b128(kvrs, (int)gvo, (int)((j) * (64 * UP * 2)), 0)
#define VTILE(j) __builtin_amdgcn_raw_buffer_load_b128(kvrs, (int)gvo + 1024, (int)((j) * (64 * UP * 2)), 0)
    const int kwo = srow * AK_ROWB + sch * 16, vwo = (sch >> 2) * 4096 + (srow >> 4) * 1024 + (srow & 15) * 64 + (sch & 3) * 16;
    const int kro = r32 * AK_ROWB + hi * 16;
    const int vro = ((lane >> 4) & 1) * 32 + (lane & 3) * 8 + (4 * hi + ((lane & 15) >> 2)) * 64;
    bf16x8 qr[2][2];
#pragma unroll
    for (int c = 0; c < 2; ++c)
#pragma unroll
        for (int ks = 0; ks < 2; ++ks) qr[c][ks] = __builtin_bit_cast(bf16x8, pre[c * 2 + ks]);
    const f32x16 zero16 = {0.f, 0.f, 0.f, 0.f, 0.f, 0.f, 0.f, 0.f, 0.f, 0.f, 0.f, 0.f, 0.f, 0.f, 0.f, 0.f};
    f32x16 o[2][2];
#pragma unroll
    for (int c = 0; c < 2; ++c)
#pragma unroll
        for (int d0 = 0; d0 < 2; ++d0) o[c][d0] = zero16;
    const short selv = (((lane >> 4) ^ lane) & 1) ? (short)0 : (short)0x3F80;
    const bf16x8 sel = (bf16x8){selv, selv, selv, selv, selv, selv, selv, selv};
    f32x4 l0 = {0.f, 0.f, 0.f, 0.f}, l1 = {0.f, 0.f, 0.f, 0.f};
    constexpr int NT = SEQ / 64;
    f32x16 S[2][2]; u32x4 PW[2][4]; bf16x8 kf[4]; s16x4 vl[4], vh[4];
    __syncthreads();
    u32x4 kst, vst;
    { const u32x4 k0_ = pre[4], k1_ = pre[5], k2_ = pre[6], k3_ = pre[7];
      const u32x4 v0_ = pre[8], v1_ = pre[9], v2_ = pre[10];
      kst = pre[11]; vst = pre[12];
      *(LAS u32x4*)(lds + ALDS_K + kwo) = k0_; *(LAS u32x4*)(lds + ALDS_K + AK_BYTES + kwo) = k1_; *(LAS u32x4*)(lds + ALDS_K + 2 * AK_BYTES + kwo) = k2_; *(LAS u32x4*)(lds + ALDS_K + 3 * AK_BYTES + kwo) = k3_;
      *(LAS u32x4*)(lds + ALDS_V + vwo) = v0_; *(LAS u32x4*)(lds + ALDS_V + AV_BYTES + vwo) = v1_; *(LAS u32x4*)(lds + ALDS_V + 2 * AV_BYTES + vwo) = v2_; }
    __syncthreads();
    { LAS const unsigned char* kb_ = lds + ALDS_K + kro;
      bf16x8 k8[8];
#pragma unroll
      for (int i_ = 0; i_ < 8; ++i_) k8[i_] = *(LAS const bf16x8*)(kb_ + ((i_ >> 1) & 1) * 32 * AK_ROWB + (4 * (i_ >> 2) + 2 * (i_ & 1)) * 16);
#pragma unroll
      for (int c = 0; c < 2; ++c)
#pragma unroll
          for (int hf = 0; hf < 2; ++hf) { S[c][hf] = __builtin_amdgcn_mfma_f32_32x32x16_bf16(k8[c * 4 + hf * 2], qr[c][0], zero16, 0, 0, 0);
              S[c][hf] = __builtin_amdgcn_mfma_f32_32x32x16_bf16(k8[c * 4 + hf * 2 + 1], qr[c][1], S[c][hf], 0, 0, 0); }
#pragma unroll
      for (int c = 0; c < 2; ++c)
#pragma unroll
          for (int hf = 0; hf < 2; ++hf) {
#pragma unroll
              for (int r = 0; r < 16; ++r) S[c][hf][r] = __builtin_amdgcn_exp2f(S[c][hf][r]);
#pragma unroll
              for (int s_ = 0; s_ < 2; ++s_) PW[c][hf * 2 + s_] = (u32x4){pk2(S[c][hf][8 * s_], S[c][hf][8 * s_ + 1]), pk2(S[c][hf][8 * s_ + 2], S[c][hf][8 * s_ + 3]), pk2(S[c][hf][8 * s_ + 4], S[c][hf][8 * s_ + 5]), pk2(S[c][hf][8 * s_ + 6], S[c][hf][8 * s_ + 7])};
          }
      LAS const unsigned char* kb1_ = lds + ALDS_K + AK_BYTES + kro;
#pragma unroll
      for (int c = 0; c < 2; ++c) { S[c][0] = __builtin_amdgcn_mfma_f32_32x32x16_bf16(kfrag(kb1_, 4 + c), qr[c][0], zero16, 0, 0, 0);
          S[c][0] = __builtin_amdgcn_mfma_f32_32x32x16_bf16(kfrag(kb1_, 6 + c), qr[c][1], S[c][0], 0, 0, 0); }
      kf[0] = kfrag(kb1_, 0); kf[1] = kfrag(kb1_, 1);
      LAS const unsigned char* vb0_ = lds + ALDS_V + vro;
#pragma unroll
      for (int d0 = 0; d0 < 2; ++d0) { vl[d0] = vtr(vb0_ + d0 * 4096); vh[d0] = vtr(vb0_ + d0 * 4096 + 512); }
    }
#define A_W5(x) ((x) >= ARING ? (x) - ARING : (x))
#define A_STEP(t, BAR) do { \
        const int s1_ = A_W5(sv + 1), s2_ = A_W5(sv + 2), s3_ = A_W5(sv + 3), s4_ = A_W5(sv + 4); \
        LAS const unsigned char* vb = vbP; LAS const unsigned char* vbn = lds + ALDS_V + s1_ * AV_BYTES + vro; \
        LAS const unsigned char* kbA = kbP; LAS const unsigned char* kbB = lds + ALDS_K + s2_ * AK_BYTES + kro; \
        attn_hgroup<0>(o, S, PW, vl, vh, kf, qr, vb, vbn, kbA, kbB, l0, l1, sel, zero16); attn_hgroup<1>(o, S, PW, vl, vh, kf, qr, vb, vbn, kbA, kbB, l0, l1, sel, zero16); \
        attn_hgroup<2>(o, S, PW, vl, vh, kf, qr, vb, vbn, kbA, kbB, l0, l1, sel, zero16); attn_hgroup<3>(o, S, PW, vl, vh, kf, qr, vb, vbn, kbA, kbB, l0, l1, sel, zero16); \
        { *(LAS u32x4*)(lds + ALDS_K + s4_ * AK_BYTES + kwo) = kst; *(LAS u32x4*)(lds + ALDS_V + s3_ * AV_BYTES + vwo) = vst; \
          const int kj_ = (t) + 4 < NT ? (t) + 4 : NT - 1, vj_ = (t) + 3 < NT ? (t) + 3 : NT - 1; \
          kst = KTILE(kj_); vst = VTILE(vj_); SBAR(); } \
        attn_hgroup<4>(o, S, PW, vl, vh, kf, qr, vb, vbn, kbA, kbB, l0, l1, sel, zero16); attn_hgroup<5>(o, S, PW, vl, vh, kf, qr, vb, vbn, kbA, kbB, l0, l1, sel, zero16); \
        attn_hgroup<6>(o, S, PW, vl, vh, kf, qr, vb, vbn, kbA, kbB, l0, l1, sel, zero16); attn_hgroup<7>(o, S, PW, vl, vh, kf, qr, vb, vbn, kbA, kbB, l0, l1, sel, zero16); \
        if (BAR) { asm volatile("s_waitcnt lgkmcnt(0)" ::: "memory"); __builtin_amdgcn_s_barrier(); asm volatile("" ::: "memory"); } \
        sv = s1_; vbP = vbn; kbP = kbB; } while (0)
    int sv = 0;
    LAS const unsigned char* vbP = lds + ALDS_V + vro; LAS const unsigned char* kbP = lds + ALDS_K + AK_BYTES + kro;
#pragma unroll 1
    for (int t = 1; t < NT - 1; t += 2) { A_STEP(t, false); A_STEP(t + 1, true); }
    A_STEP(NT - 1, false);
#undef A_STEP
#undef A_W5
#undef KTILE
#undef VTILE
    {
        LAS const unsigned char* vb_ = lds + ALDS_V + ((NT - 1) % ARING) * AV_BYTES + vro;
#pragma unroll
        for (int ks = 0; ks < 4; ++ks)
#pragma unroll
            for (int d0 = 0; d0 < 2; ++d0) {
                const s16x4 lo_ = vtr(vb_ + d0 * 4096 + ks * 1024), hi_ = vtr(vb_ + d0 * 4096 + ks * 1024 + 512);
                const bf16x8 vf_ = (bf16x8){lo_[0], lo_[1], lo_[2], lo_[3], hi_[0], hi_[1], hi_[2], hi_[3]};
                o[0][d0] = __builtin_amdgcn_mfma_f32_32x32x16_bf16(__builtin_bit_cast(bf16x8, PW[0][ks]), vf_, o[0][d0], 0, 0, 0);
                o[1][d0] = __builtin_amdgcn_mfma_f32_32x32x16_bf16(__builtin_bit_cast(bf16x8, PW[1][ks]), vf_, o[1][d0], 0, 0, 0); }
#pragma unroll
        for (int ks = 0; ks < 4; ++ks) {
            l0 = __builtin_amdgcn_mfma_f32_16x16x32_bf16(__builtin_bit_cast(bf16x8, PW[0][ks]), sel, l0, 0, 0, 0);
            l1 = __builtin_amdgcn_mfma_f32_16x16x32_bf16(__builtin_bit_cast(bf16x8, PW[1][ks]), sel, l1, 0, 0, 0); }
    }
    attn_preload(A, next_unit, wv, pre);
    asm volatile("s_waitcnt lgkmcnt(0)" ::: "memory"); __syncthreads();
    LAS float* wsf = (LAS float*)(lds + ALDS_WS) + wid * 64;
    if ((lane & 15) < 2) {
#pragma unroll
        for (int r = 0; r < 4; ++r) { const int qr_ = 4 * (lane >> 4) + r + 16 * (lane & 15); wsf[qr_] = __builtin_amdgcn_rcpf(l0[r]); wsf[32 + qr_] = lam * __builtin_amdgcn_rcpf(l1[r]); } }
    LDS_WAIT();
    LAS float* stg = (LAS float*)(lds + ALDS_STG + wid * ASTG_BYTES);
#pragma unroll
    for (int r = 0; r < 16; ++r) { const int row = crow(r, hi); const float i0 = wsf[row], i1 = wsf[32 + row];
#pragma unroll
        for (int d0 = 0; d0 < 2; ++d0) stg[row * ASTG_ROW + d0 * 32 + r32] = o[0][d0][r] * i0 - o[1][d0][r] * i1; }
    LDS_WAIT();
    const float* sg = INP(A, I_SUBG) + layer * 64;
    const int ch = lane & 7;
    const f32x4 g0 = *(const f32x4*)(sg + ch * 8), g1 = *(const f32x4*)(sg + ch * 8 + 4);
#pragma unroll
    for (int i = 0; i < 4; ++i) { const int row = i * 8 + (lane >> 3);
        const f32x4 v0 = *(LAS const f32x4*)(stg + row * ASTG_ROW + ch * 8), v1 = *(LAS const f32x4*)(stg + row * ASTG_ROW + ch * 8 + 4);
        float ss = (v0[0] * v0[0] + v0[1] * v0[1]) + (v0[2] * v0[2] + v0[3] * v0[3]) + (v1[0] * v1[0] + v1[1] * v1[1]) + (v1[2] * v1[2] + v1[3] * v1[3]);
        ss += __shfl_xor(ss, 1); ss += __shfl_xor(ss, 2); ss += __shfl_xor(ss, 4);
        const float inv = (1.f - lam_init) * __builtin_amdgcn_rsqf(ss * (1.f / 64.f) + EPS);
        store8(AB + (tok0 + q0 + row) * AP + h * 64 + ch * 8, v0 * inv * g0, v1 * inv * g1); }
    __syncthreads();
}


__device__ __forceinline__ void conv_item(const Args& A, int layer, int item, LAS unsigned char* lds, int wv, u32x2 (&zr)[16]) {
    int tid = my_tid(wv); const int lane = tid & 63, wave = tid >> 6; unsigned char* ws = A.ws;
    const bf16_t* U = (const bf16_t*)(ws + WS_U); bf16_t* AB = (bf16_t*)(ws + WS_ABUF);
    const int b = item >> 7, t0 = (item & 127) * 64;
    const float* cw = INP(A, I_CW) + (size_t)layer * CONVW * 512;
    typedef __attribute__((address_space(1))) f32x2 gf32x2_; typedef __attribute__((address_space(1))) unsigned gu32_;
    const int cp = tid & 255, th = tid >> 8;
    f32x2 w2[CONVW], pv[CONVW], cu[CONVW];
#pragma unroll
    for (int j = 0; j < CONVW; ++j) w2[j] = *(const gf32x2_*)(cw + j * 512 + 2 * cp);
    const f32x2 bias2 = *(const gf32x2_*)(INP(A, I_CB) + layer * 512 + 2 * cp);
    LAS float* T = (LAS float*)lds;
    LAS f32x2* st = (LAS f32x2*)(lds + 64 * 513 * 4);
    const bf16_t* gin2 = U + ((size_t)b * SEQ) * UP + 1536 + 2 * cp;
    __syncthreads();
    { unsigned rp[CONVW], rc[CONVW];
#pragma unroll
      for (int i = 0; i < CONVW; ++i) { const int ti = t0 + th * 32 + i - 15, tc = ti < 0 ? 0 : (ti > SEQ - 1 ? SEQ - 1 : ti); rp[i] = *(const gu32_*)(gin2 + (size_t)tc * UP); }
#pragma unroll
      for (int i = 0; i < CONVW; ++i) { const int ti = t0 + th * 32 + CONVW + i - 15, tc = ti < 0 ? 0 : (ti > SEQ - 1 ? SEQ - 1 : ti); rc[i] = *(const gu32_*)(gin2 + (size_t)tc * UP); }
      { typedef __attribute__((address_space(1))) u32x2 gu32x2_; const int fb = item >> 7, fg = (item >> 5) & 3, fkp = item & 31;
        const bf16_t* zin = U + (size_t)fb * SEQ * UP + 2048 + fg * 128 + 4 * fkp;
#pragma unroll
        for (int na = 0; na < 16; ++na) zr[na] = *(const gu32x2_*)(zin + (size_t)(na * 512 + tid) * UP);
        __builtin_amdgcn_sched_barrier(0); }
#pragma unroll
      for (int i = 0; i < CONVW; ++i) { const int ti = t0 + th * 32 + i - 15; pv[i] = (ti >= 0 && ti < SEQ) ? (f32x2){bflo(rp[i]), bfhi(rp[i])} : (f32x2){0.f, 0.f}; }
#pragma unroll
      for (int i = 0; i < CONVW; ++i) { const int ti = t0 + th * 32 + CONVW + i - 15; cu[i] = (ti >= 0 && ti < SEQ) ? (f32x2){bflo(rc[i]), bfhi(rc[i])} : (f32x2){0.f, 0.f}; } }
    { f32x2 s2 = bias2;
#pragma unroll
      for (int j = 0; j < CONVW; ++j) s2 += pv[j] * w2[j];
      T[(th * 32) * 513 + 2 * cp] = s2.x; T[(th * 32) * 513 + 2 * cp + 1] = s2.y; }
#pragma unroll
    for (int p = 0; p < CONVW; ++p) {
        f32x2 s2 = bias2;
#pragma unroll
        for (int j = 0; j < CONVW; ++j) { const int q = 1 + p + j; s2 += (q < CONVW ? pv[q] : cu[q - CONVW]) * w2[j]; }
        T[(th * 32 + 1 + p) * 513 + 2 * cp] = s2.x; T[(th * 32 + 1 + p) * 513 + 2 * cp + 1] = s2.y;
    }
    const int c = tid;
    __syncthreads();
#pragma unroll
    for (int i = 0; i < 8; ++i) { const int t = wave * 8 + i; float s = 0.f, s2 = 0.f;
#pragma unroll
        for (int k = 0; k < 8; ++k) { const float v = T[t * 513 + lane + 64 * k]; s += v; }
        s = wave_sum(s); const float mean = s * (1.f / 512.f);
#pragma unroll
        for (int k = 0; k < 8; ++k) { const float v = T[t * 513 + lane + 64 * k] - mean; s2 += v * v; }
        s2 = wave_sum(s2);
        if (lane == 0) st[t] = (f32x2){mean, 1.0f / sqrtf(s2 * (1.f / 512.f) + EPS)}; }
    __syncthreads();
    const float lg = INP(A, I_CLG)[layer * 512 + c], lb = INP(A, I_CLB)[layer * 512 + c];
    bf16_t* op = AB + ((size_t)b * SEQ + t0) * AP + 512 + c;
#pragma unroll 8
    for (int t = 0; t < 64; ++t) { const f32x2 s = st[t]; const float y = (T[t * 513 + c] - s.x) * s.y * lg + lb; op[(size_t)t * AP] = f2bf(y * sigmoidf_(y)); }
    __syncthreads();
}

constexpr float C32[16] = {1.0f, 0.98078528040323043f, 0.92387953251128674f, 0.83146961230254524f, 0.70710678118654757f, 0.55557023301960229f, 0.38268343236508984f, 0.19509032201612833f,
                           0.0f, -0.19509032201612819f, -0.38268343236508973f, -0.55557023301960196f, -0.70710678118654746f, -0.83146961230254535f, -0.92387953251128674f, -0.98078528040323043f};
constexpr float S32[16] = {0.0f, 0.19509032201612825f, 0.38268343236508978f, 0.55557023301960218f, 0.70710678118654746f, 0.83146961230254524f, 0.92387953251128674f, 0.98078528040323043f,
                           1.0f, 0.98078528040323043f, 0.92387953251128674f, 0.83146961230254546f, 0.70710678118654757f, 0.55557023301960218f, 0.38268343236508989f, 0.19509032201612861f};
__device__ __forceinline__ f32x2 cmul(f32x2 a, f32x2 w) { return (f32x2){a.x * w.x - a.y * w.y, a.x * w.y + a.y * w.x}; }
template <int N> __device__ __forceinline__ void fft_dif(f32x2 (&v)[N]) {
#pragma unroll
    for (int len = N; len >= 2; len >>= 1) {
        const int half = len >> 1, step = 32 / len;
#pragma unroll
        for (int i = 0; i < N; i += len)
#pragma unroll
            for (int j = 0; j < half; ++j) {
                const f32x2 a = v[i + j], b = v[i + j + half]; v[i + j] = a + b; f32x2 d = a - b;
                const int ti = j * step;
                if (ti == 0) v[i + j + half] = d;
                else if (ti == 8) v[i + j + half] = (f32x2){d.y, -d.x};
                else v[i + j + half] = (f32x2){d.x * C32[ti] + d.y * S32[ti], d.y * C32[ti] - d.x * S32[ti]};
            }
    }
}
template <int BITS> __device__ __forceinline__ constexpr int brev(int x) { int r = 0; for (int i = 0; i < BITS; ++i) r |= ((x >> i) & 1) << (BITS - 1 - i); return r; }

__device__ __forceinline__ void fft_item(const Args& A, int item, LAS unsigned char* lds, int wv, const u32x2 (&zr)[16]) {
    int tid = my_tid(wv); unsigned char* ws = A.ws;
    const bf16_t* U = (const bf16_t*)(ws + WS_U); bf16_t* AB = (bf16_t*)(ws + WS_ABUF); const f32x2* tw = (const f32x2*)(ws + WS_TW);
    const int b = item >> 7, g = (item >> 5) & 3, kp = item & 31;
    const bf16_t* zin = U + (size_t)b * SEQ * UP + 2048 + g * 128 + 4 * kp;
    LAS f32x2* L0 = (LAS f32x2*)lds; LAS f32x2* L1 = L0 + 256 * 33;
    __syncthreads();
    {
        f32x2 x0[16], x1[16];
#pragma unroll
        for (int na = 0; na < 16; ++na) { const u32x2 raw = zr[na]; x0[na] = (f32x2){bflo(raw.x), bfhi(raw.x)}; x1[na] = (f32x2){bflo(raw.y), bfhi(raw.y)}; }
        fft_dif<16>(x0); fft_dif<16>(x1);
        const int nb = tid >> 5, nc = tid & 31;
#pragma unroll
        for (int ka = 0; ka < 16; ++ka) { const f32x2 w = tw[(32 * nb * ka) & 8191]; const int idx = (ka * 16 + nb) * 33 + nc; L0[idx] = cmul(x0[brev<4>(ka)], w); L1[idx] = cmul(x1[brev<4>(ka)], w); }
    }
    f32x2 tw2[16];
    { const int ka = tid >> 5, nc = tid & 31;
#pragma unroll
      for (int kb = 0; kb < 16; ++kb) tw2[kb] = tw[(nc * (ka + 16 * kb)) & 8191]; }
    __syncthreads();
    {
        const int ka = tid >> 5, nc = tid & 31;
        f32x2 x0[16], x1[16];
#pragma unroll
        for (int nb = 0; nb < 16; ++nb) { const int idx = (ka * 16 + nb) * 33 + nc; x0[nb] = L0[idx]; x1[nb] = L1[idx]; }
        fft_dif<16>(x0); fft_dif<16>(x1);
#pragma unroll
        for (int kb = 0; kb < 16; ++kb) { const f32x2 w = tw2[kb]; const int idx = (ka * 16 + kb) * 33 + nc; L0[idx] = cmul(x0[brev<4>(kb)], w); L1[idx] = cmul(x1[brev<4>(kb)], w); }
    }
    __syncthreads();
    {
        LAS f32x2* L = (tid >> 8) ? L1 : L0; const int i2 = tid & 255;
        f32x2 x[32];
#pragma unroll
        for (int nc = 0; nc < 32; ++nc) x[nc] = L[i2 * 33 + nc];
        fft_dif<32>(x);
#pragma unroll
        for (int kc = 0; kc < 32; ++kc) L[i2 * 33 + kc] = x[brev<5>(kc)];
    }
    __syncthreads();
    bf16_t* orow = AB + (size_t)b * SEQ * AP + 1024 + g * 128;
#pragma unroll 4
    for (int pass = 0; pass < 16; ++pass) {
        const int kc = tid & 31, i2 = pass * 16 + (tid >> 5), ka = i2 >> 4, kb = i2 & 15;
        const int k = ka + 16 * kb + 256 * kc, km = (SEQ - k) & (SEQ - 1);
        const int im = ((km & 15) * 16 + ((km >> 4) & 15)) * 33 + (km >> 8);
        const f32x2 a0 = L0[i2 * 33 + kc], a1 = L1[i2 * 33 + kc], m0 = L0[im], m1 = L1[im];
        bf16_t* o = orow + (size_t)k * AP + 4 * kp;
        u32x2 w;
        if (kp == 0) { w.x = pk2(0.5f * (a0.x + m0.x), a1.x); w.y = pk2(m1.x, 0.5f * (a0.y + m0.y)); }
        else { w.x = pk2(a0.x, a1.x); w.y = pk2(m1.x, m0.x); }
        *(u32x2*)o = w;
    }
    __syncthreads();
}

#if FAST_GEMM
#define RUN_GEMM(g, S, E) gemm_phase<decltype(E), decltype(S), true, true>(lds, g, S, E, wv)
#define RUN_GEMM_T(g, S, E) gemm_phase<decltype(E), TailHalfOrder, true, true>(lds, g, S, E, wv)
#else
#define RUN_GEMM(g, S, E) gemm_phase_simple(lds, g, S, E, wv)
#define RUN_GEMM_T(g, S, E) gemm_phase_simple(lds, g, S, E, wv)
#endif
#define XB_TMO      128
#define XB_XCNT(j)  (256  + 64 * (j))
#define XB_XSUB(j)  (1280 + 64 * (j))
#define XB_XGEN(j)  (2304 + 64 * (j))
#define XB_TOP      3328
#define XB_TOPGEN   3392
#define XCD_BAR_WORDS 3456
#define XB_SPIN_CAP (1u << 22)
__device__ __forceinline__ unsigned xb_ld(unsigned* p)              { return __hip_atomic_load(p, __ATOMIC_RELAXED, __HIP_MEMORY_SCOPE_AGENT); }
__device__ __forceinline__ unsigned xb_add(unsigned* p, unsigned v) { return __hip_atomic_fetch_add(p, v, __ATOMIC_RELAXED, __HIP_MEMORY_SCOPE_AGENT); }
__device__ __forceinline__ unsigned xb_xcc_id() { return (unsigned)__builtin_amdgcn_s_getreg((3 << 11) | 20) & 0xFu; }
#define XB_SPIN(cond, bar) do { unsigned _sp = 0; while (cond) { __builtin_amdgcn_s_sleep(1); \
    if ((++_sp & 255u) == 0u) { if (xb_ld(&(bar)[XB_TMO])) break; if (_sp > XB_SPIN_CAP) { atomicAdd(&(bar)[XB_TMO], 1u); break; } } } } while (0)
struct XcdBarrier { unsigned* bar; unsigned x; volatile LAS unsigned* st; };
__device__ __forceinline__ XcdBarrier xcd_barrier_post(unsigned* bar, volatile LAS unsigned* st, bool leader) {
    XcdBarrier b; b.bar = bar; b.x = xb_xcc_id(); b.st = st;
    if (leader) (void)xb_add(&bar[XB_XCNT(b.x)], 1u);
    return b;
}
__device__ __forceinline__ void xcd_barrier_complete(unsigned* bar, unsigned x, int lane, volatile LAS unsigned* st) {
    const unsigned G = gridDim.x * gridDim.y * gridDim.z;
    unsigned c, sp = 0u;
    for (;;) {
        c = lane < 16 ? xb_ld(&bar[XB_XCNT(lane)]) : 0u;
        unsigned sum = c;
#pragma unroll
        for (int o = 1; o < 64; o <<= 1) sum += (unsigned)__builtin_amdgcn_ds_bpermute((lane ^ o) << 2, (int)sum);
        if (sum == G) break;
        __builtin_amdgcn_s_sleep(1);
        if ((++sp & 255u) == 0u) { if (__builtin_amdgcn_readfirstlane(xb_ld(&bar[XB_TMO]))) break; if (sp > XB_SPIN_CAP) { if (lane == 0) atomicAdd(&bar[XB_TMO], 1u); break; } }
    }
    const unsigned cnt = (unsigned)__builtin_popcountll(__ballot(c > 0u)), mine = (unsigned)__builtin_amdgcn_readlane((int)c, (int)x);
    if (lane == 0) { st[0] = mine > 0u ? mine : 1u; st[1] = cnt > 0u ? cnt : 1u; }
}
__device__ __forceinline__ void window_work(const Args& A, int ph, LAS unsigned char* lds, int wv) {
    const int layer = ph / NPHASE, p = ph % NPHASE;
    const int w = p == 1 ? 1 : (p == 2 ? 2 : (p == 4 ? 3 : (p == 5 ? 4 : (p == 6 ? 5 : (p == 7 ? 6 : 0)))));
    if (w == 0) return;
    const int tid = my_tid(wv), lane = tid & 63, wave = __builtin_amdgcn_readfirstlane(tid >> 6);
    const int NSW = (int)gridDim.x * (NWAVES - 1), sw = (int)blockIdx.x * (NWAVES - 1) + wave - 1;
    LAS float* scr = (LAS float*)(lds + wave * 16384);
    constexpr int LQ = (PI_LATE + 3) / 4;
    if (w <= 4) { const int lo = (w - 1) * LQ, hi = lo + LQ < PI_LATE ? lo + LQ : PI_LATE;
        for (int i = lo + sw; i < hi; i += NSW) prep_item(A, layer, PI_EARLY + i, scr, lane); }
    if (w >= 3 && layer + 1 < DEPTH) {
        constexpr int ET = PI_EARLY + PI_FOLD, E34 = 1040, EH = 2 * E34 + (ET - 2 * E34 + 1) / 2;
        const int lo = w == 3 ? 0 : (w == 4 ? E34 : (w == 5 ? 2 * E34 : EH)), hi = w == 3 ? E34 : (w == 4 ? 2 * E34 : (w == 5 ? EH : ET));
        const int s0 = w <= 4 ? (sw + NSW - (LQ % NSW)) % NSW : sw;
        LAS f32x2* cs = (LAS f32x2*)(scr + 64 * 33);
        if (hi > PI_EARLY) { float s_, c_; sincospif((float)lane * (1.f / 64.f), &s_, &c_); cs[lane] = (f32x2){c_, s_}; sincospif((float)(lane + 64) * (1.f / 64.f), &s_, &c_); cs[lane + 64] = (f32x2){c_, s_}; LDS_WAIT(); }
        for (int e = lo + s0; e < hi; e += NSW) { if (e < PI_EARLY) prep_item(A, layer + 1, e, scr, lane); else fold_task(A, layer + 1, e - PI_EARLY, cs, lane); }
    }
}
__device__ __forceinline__ void xcd_barrier(const XcdBarrier& b, int tid, const Args& A, int ph, LAS unsigned char* lds, int wv) {
    const bool leader = tid == 0;
    asm volatile("s_waitcnt vmcnt(0)" ::: "memory");
    __syncthreads();
    if (b.st[0] == 0u) {
        if (tid < 64) xcd_barrier_complete(b.bar, b.x, tid, b.st);
        __syncthreads();
    }
    if (tid >= 64) window_work(A, ph, lds, wv);
    else if (leader) {
        unsigned* bar = b.bar;
        __builtin_amdgcn_s_waitcnt(0);
        const unsigned nloc = b.st[0], nx = b.st[1];
        const unsigned old = xb_add(&bar[XB_XSUB(b.x)], 1u);
        const unsigned gen = old / nloc;
        if (old + 1u == (gen + 1u) * nloc) {
            __builtin_amdgcn_fence(__ATOMIC_RELEASE, "agent");
            asm volatile("s_waitcnt vmcnt(0)" ::: "memory");
            const unsigned og = xb_add(&bar[XB_TOP], 1u);
            const unsigned tg = og / nx;
            if (og + 1u == (tg + 1u) * nx) {
#pragma unroll
                for (unsigned j = 0; j < 16; ++j) xb_add(&bar[XB_XGEN(j)], 1u);
                xb_add(&bar[XB_TOPGEN], 1u);
            } else XB_SPIN(xb_ld(&bar[XB_XGEN(b.x)]) == gen, bar);
            __builtin_amdgcn_fence(__ATOMIC_ACQUIRE, "agent");
            asm volatile("s_waitcnt vmcnt(0)" ::: "memory");
        } else {
            XB_SPIN(xb_ld(&bar[XB_XGEN(b.x)]) == gen, bar);
            __builtin_amdgcn_fence(__ATOMIC_ACQUIRE, "agent");
            asm volatile("s_waitcnt vmcnt(0)" ::: "memory");
        }
    }
    __syncthreads();
}

__global__ void __launch_bounds__(NTHREADS, 2) fwd_kernel(Args A) {
    extern __shared__ __attribute__((aligned(16))) unsigned char lds_raw[];
    LAS unsigned char* lds = (LAS unsigned char*)lds_raw;
    cg::grid_group grid = cg::this_grid();
    const int wv = __builtin_amdgcn_readfirstlane(threadIdx.x >> 6);
    volatile LAS unsigned* bst = (volatile LAS unsigned*)(lds + LDS_BYTES - 16);
    if (threadIdx.x == 0) { bst[0] = 0u; bst[1] = 0u; }
    __syncthreads();
    const XcdBarrier xbar = xcd_barrier_post((unsigned*)(A.ws + WS_BAR), bst, threadIdx.x == 0);
    const int G = gridDim.x;
    for (int ph = A.ph_lo; ph < A.ph_hi; ++ph) {
        if (ph > A.ph_lo && ph % NPHASE != 3 && !(ph % NPHASE == 0 && MK_ONE_LAUNCH)) { if (ph < 0) grid.sync(); else xcd_barrier(xbar, my_tid(wv), A, ph, lds, wv); }
        unsigned char* ws = A.ws; asm volatile("" : "+s"(ws));
        int bid = blockIdx.x; asm volatile("" : "+s"(bid));
        bf16_t* XB = (bf16_t*)(ws + WS_XB); bf16_t* AB = (bf16_t*)(ws + WS_ABUF); bf16_t* UU = (bf16_t*)(ws + WS_U); bf16_t* MG = (bf16_t*)(ws + WS_MRG);
        float* ssqA = (float*)(ws + WS_SSQA); float* ssqB = (float*)(ws + WS_SSQB);
        const int layer = ph / NPHASE, p = ph % NPHASE;
        StaticOrder S;
        if (p == 0) {
            if (PHON(0) && (layer == 0 || !MK_ONE_LAUNCH)) p0_prep(A, layer, lds, G, wv, !MK_ONE_LAUNCH);
        } else if (p == 1 && PHON(1)) {
            Gemm g{XB, (const bf16_t*)(ws + WS_WIN), M, NIN + NGATE, DM}; StaticOrderT<P1_WGM, 12> S; S.init(M, NIN + NGATE, G, bid);
            EpiInGate E{EpiIn{UU, ssqA, INP(A, I_QNG) + layer * 32, INP(A, I_KNG) + layer * 32, (const f32x2*)(ws + WS_ROPE)}, EpiGate{ws + WS_GATE, ssqA, INP(A, I_BGATE) + layer * NGATE}, ssqA};
            RUN_GEMM(g, S, E);
        } else if (p == 2) {
            const int vcu = (G % 8 == 0) ? (bid % 8) * (G / 8) + (bid / 8) : bid;
            if (PHON(8)) {
#if FAST_ATTN
                const float* gq = INP(A, I_QNG) + layer * 32; const float* gk = INP(A, I_KNG) + layer * 32;
                const int li = my_tid(wv) & 31;
                float gqm = fabsf(gq[li]), gkm = fabsf(gk[li]), d1 = INP(A, I_LQ1)[layer * 32 + li] * INP(A, I_LK1)[layer * 32 + li], d2 = INP(A, I_LQ2)[layer * 32 + li] * INP(A, I_LK2)[layer * 32 + li];
#pragma unroll
                for (int o = 1; o < 32; o <<= 1) { gqm = fmaxf(gqm, __shfl_xor(gqm, o)); gkm = fmaxf(gkm, __shfl_xor(gkm, o)); d1 += __shfl_xor(d1, o); d2 += __shfl_xor(d2, o); }
#define RFL_F(x) x = __builtin_bit_cast(float, __builtin_amdgcn_readfirstlane(__builtin_bit_cast(int, x)))
                RFL_F(gqm); RFL_F(gkm); RFL_F(d1); RFL_F(d2);
#undef RFL_F
                const float lam_init = 0.8f - 0.6f * expf(-0.3f * (float)layer), lam = expf(d1) - expf(d2) + lam_init, bound = QSCALE * 32.f * gqm * gkm;
                if (vcu < 512) { u32x4 pre[13]; attn_preload(A, vcu, wv, pre);
                  for (int u = vcu; u < 512; u += G) { const int nu = u + G < 512 ? u + G : u; attn_unit_fast(A, layer, u, nu, lds, bound, lam, lam_init, wv, pre); } }
#else
                for (int u = blockIdx.x; u < 1024; u += G) attn_unit_ref(A, layer, u, lds, wv);
#endif
            }
            if (PHON(9) && PHON(10)) for (int u = vcu; u < 256; u += G) { u32x2 zr[16]; conv_item(A, layer, u, lds, wv, zr); fft_item(A, u, lds, wv, zr); }
        } else if (p == 4 && PHON(4)) {
            Gemm g{AB, (const bf16_t*)(ws + WS_WM), M, DM, KMRG}; S.init(M, DM, G, bid);
            EpiMerge E{nullptr, ws + WS_GATE, MG};
            RUN_GEMM(g, S, E);
        } else if (p == 5 && PHON(5)) {
            Gemm g{MG, (const bf16_t*)(ws + WS_WO), M, DM, DM}; S.init(M, DM, G, bid);
            EpiRes<false> E{nullptr, XB, ssqB};
            RUN_GEMM(g, S, E);
        } else if (p == 6 && PHON(6)) {
            Gemm g{XB, (const bf16_t*)(ws + WS_WF1), M, NF1, DM}; TailHalfOrder T; T.init(M, NF1, G, bid);
            EpiFfnIn E{UU, ssqB};
            RUN_GEMM_T(g, T, E);
        } else if (p == 7 && PHON(7)) {
            Gemm g{UU, (const bf16_t*)(ws + ((layer & 1) ? WS_WF2B : WS_WF2)), M, DM, DFF}; S.init(M, DM, G, bid);
            if (layer == DEPTH - 1) { EpiRes<true> E{A.out, XB, ssqA}; RUN_GEMM(g, S, E); }
            else { EpiRes<false> E{nullptr, XB, ssqA}; RUN_GEMM(g, S, E); }
        }
    }
}

extern "C" void kernel_launch(void* const* d_in, const int* in_sizes, int n_in, void* d_out, int out_size, void* d_ws, size_t ws_size, hipStream_t stream) {
    static int grid = 0;
    if (grid == 0) {
        if (n_in != 23 || out_size != M * DM || ws_size < WS_END) { fprintf(stderr, "kernel_launch: unexpected shapes (n_in %d, out %d, ws %zu)\n", n_in, out_size, ws_size); grid = -1; return; }
        int dev = 0, cus = 0, per_cu = 0;
        (void)hipGetDevice(&dev); (void)hipDeviceGetAttribute(&cus, hipDeviceAttributeMultiprocessorCount, dev);
        (void)hipFuncSetAttribute((const void*)fwd_kernel, hipFuncAttributeMaxDynamicSharedMemorySize, LDS_BYTES);
        (void)hipOccupancyMaxActiveBlocksPerMultiprocessor(&per_cu, (const void*)fwd_kernel, NTHREADS, LDS_BYTES);
        if (per_cu < 1) { fprintf(stderr, "kernel_launch: occupancy query says %d blocks per CU\n", per_cu); per_cu = 1; }
        (void)hipGetLastError();
        grid = cus * per_cu;
    }
    if (grid < 0) return;
    (void)hipMemsetAsync((unsigned char*)d_ws + WS_BAR, 0, 16384, stream);
    Args a{};
    for (int i = 0; i < 23; ++i) a.in[i] = (const float*)d_in[i];
    a.out = (float*)d_out; a.ws = (unsigned char*)d_ws;
#if MK_ONE_LAUNCH
    a.ph_lo = 0; a.ph_hi = DEPTH * NPHASE;
    void* args[] = {&a};
    hipError_t e = hipLaunchCooperativeKernel((const void*)fwd_kernel, dim3(grid), dim3(NTHREADS), args, LDS_BYTES, stream);
    if (e != hipSuccess) fprintf(stderr, "cooperative launch failed: %s (grid %d)\n", hipGetErrorString(e), grid);
#else
    for (int ph = 0; ph < DEPTH * NPHASE; ++ph) { a.ph_lo = ph; a.ph_hi = ph + 1; hipLaunchKernelGGL(fwd_kernel, dim3(grid), dim3(NTHREADS), LDS_BYTES, stream, a); }
#endif
}
```
